# Optimizing an MI355X kernel written in HIP

```python
import math
import jax, jax.numpy as jnp
from jax import lax
import numpy as np

D_MODEL = 2048
BATCH = 16
SEQ = 256
DEPTH = 2
DEC_BATCH = 4
DEC_SEQ = 1024
PAST_LEN = 512

GRID_W = 64
N_MIXERS = 4
BRANCH = D_MODEL // N_MIXERS
N_GROUPS = 4
GROUP_W = BRANCH // N_GROUPS
CHUNK = 128
POOL_WINDOWS = (2, 4, 8, 16)
N_HEADS_C = 4
HEAD_DIM_C = BRANCH // N_HEADS_C
QK_HALF = HEAD_DIM_C // 2
ROPE_AXIS_DIM = QK_HALF // 2
ROPE_BASE = 10000.0
Q_BLOCK = 128
SHORT_CONV = 3
HY_BANDS = 16
HY_EMB = 1 + 2 * HY_BANDS
HY_HIDDEN = 64
HY_ORDER = 2
HY_FAST_DECAY = 0.3
HY_SLOW_DECAY = 1.5
HY_TARGET = 1e-2
N_IN_PIECES = 13
D_IN = N_IN_PIECES * BRANCH
D_MIX = N_MIXERS * BRANCH
LN_EPS = 1e-6
F32 = jnp.float32

kernel_name = "hybrid_prefix_diffusion_step"


def _layer_norm(x):
    x32 = x.astype(F32)
    mu = jnp.mean(x32, axis=-1, keepdims=True)
    xc = x32 - mu
    var = jnp.mean(xc * xc, axis=-1, keepdims=True)
    return (xc * lax.rsqrt(var + LN_EPS)).astype(x.dtype)


def _chunk_gmlp(u, v, w_s, b_s):
    b, L, _ = v.shape
    vc = _layer_norm(v).reshape(b, L // CHUNK, CHUNK, N_GROUPS, GROUP_W)
    mixed = jnp.einsum("gij,bnjgc->bnigc", w_s, vc) + jnp.swapaxes(b_s, 0, 1)[:, :, None]
    return u * mixed.reshape(b, L, BRANCH)


def _multiscale_pool(p, w_pool, pool_scale):
    b, L, _ = p.shape
    pg = p.reshape(b, L, N_GROUPS, GROUP_W)
    csum = jnp.pad(jnp.cumsum(pg.astype(F32), axis=1), ((0, 0), (1, 0), (0, 0), (0, 0)))
    t = jnp.arange(L)
    means = []
    for g, w in enumerate(POOL_WINDOWS):
        lo = jnp.clip(t - w // 2, 0, L)
        hi = jnp.clip(t + w // 2, 0, L)
        win = csum[:, hi, g] - csum[:, lo, g]
        means.append(win / (hi - lo).astype(F32)[None, :, None])
    pooled = jnp.stack(means, axis=2).astype(p.dtype)
    y = jnp.einsum("blgc,gcd->blgd", pooled - pg, w_pool)
    return y.reshape(b, L, BRANCH) * pool_scale


def _axial_angles(L):
    n_rows = L // GRID_W
    row = jnp.repeat(jnp.arange(n_rows), GRID_W).astype(F32)
    col = jnp.tile(jnp.arange(GRID_W), n_rows).astype(F32)
    inv = ROPE_BASE ** (-jnp.arange(0, ROPE_AXIS_DIM, 2, dtype=F32) / ROPE_AXIS_DIM)
    return row[:, None] * inv, col[:, None] * inv


def _rotate(x, ang):
    half = x.shape[-1] // 2
    cos = jnp.cos(ang)[None, :, None, None, :].astype(x.dtype)
    sin = jnp.sin(ang)[None, :, None, None, :].astype(x.dtype)
    x1, x2 = x[..., :half], x[..., half:]
    return jnp.concatenate([x1 * cos - x2 * sin, x2 * cos + x1 * sin], axis=-1)


def _axial_rope(x, ang_row, ang_col):
    return jnp.concatenate([_rotate(x[..., :ROPE_AXIS_DIM], ang_row),
                            _rotate(x[..., ROPE_AXIS_DIM:], ang_col)], axis=-1)


def _diff_attention(q, k, v, lam, lam_init, subln_w):
    bsz, lq = q.shape[0], q.shape[1]
    n_blk = lq // Q_BLOCK
    qb = jnp.moveaxis(q.reshape(bsz, n_blk, Q_BLOCK, N_HEADS_C, 2, QK_HALF), 1, 0)

    def block(q_blk):
        s = jnp.einsum("bqhmd,bkhmd->bhmqk", q_blk, k, preferred_element_type=F32) * (QK_HALF ** -0.5)
        p = jax.nn.softmax(s, axis=-1)
        w = (p[:, :, 0] - lam * p[:, :, 1]).astype(v.dtype)
        return jnp.einsum("bhqk,bkhd->bqhd", w, v)

    o = jnp.moveaxis(lax.map(block, qb), 0, 1).reshape(bsz, lq, N_HEADS_C, HEAD_DIM_C)
    o32 = o.astype(F32)
    o32 = o32 * lax.rsqrt(jnp.mean(o32 * o32, axis=-1, keepdims=True) + 1e-5)
    o = o32.astype(v.dtype) * subln_w * (1.0 - lam_init)
    return o.reshape(bsz, lq, BRANCH)


def _short_conv(x, w, b):
    L = x.shape[1]
    xp = jnp.pad(x, ((0, 0), (1, 1), (0, 0)))
    return xp[:, 0:L] * w[0] + xp[:, 1:L + 1] * w[1] + xp[:, 2:L + 2] * w[2] + b


def _hyena_filters(L, w1, b1, w2, b2, freq, w3):
    t_idx = jnp.arange(L, dtype=F32)
    t_norm = jnp.linspace(0.0, 1.0, L, dtype=F32)
    bands = jnp.linspace(1e-4, HY_BANDS - 1, HY_BANDS, dtype=F32)
    ang = (2.0 * math.pi * t_idx / L)[:, None] * bands[None, :]
    feats = jnp.concatenate([t_norm[:, None], jnp.cos(ang), jnp.sin(ang)], axis=-1)
    fr = freq.astype(F32)
    h = jnp.sin(fr * (feats @ w1.astype(F32) + b1.astype(F32)))
    h = jnp.sin(fr * (h @ w2.astype(F32) + b2.astype(F32)))
    h = (h @ w3.astype(F32)).reshape(L, HY_ORDER, 2, BRANCH)
    deltas = jnp.abs(jnp.linspace(math.log(HY_TARGET) / HY_FAST_DECAY,
                                  math.log(HY_TARGET) / HY_SLOW_DECAY, BRANCH, dtype=F32))
    h = h * jnp.exp(-t_norm[:, None] * deltas[None, :])[:, None, None, :]
    fwd, bwd = h[:, :, 0], h[:, :, 1]
    k = jnp.concatenate([fwd, jnp.zeros_like(fwd[:1]), bwd[1:][::-1]], axis=0)
    k = k / jnp.sum(jnp.abs(k), axis=0, keepdims=True)
    return jnp.fft.rfft(k, axis=0)


def _long_conv(z, k_f, bias):
    L = z.shape[1]
    z32 = z.astype(F32)
    y = jnp.fft.irfft(jnp.fft.rfft(z32, n=2 * L, axis=1) * k_f[None], n=2 * L, axis=1)[:, :L]
    return (y + z32 * bias.astype(F32)).astype(z.dtype)


def _hyena(x1, x2, hv, conv_w, conv_b, k_f, hy_bias):
    xc = _short_conv(jnp.concatenate([x1, x2, hv], axis=-1), conv_w, conv_b)
    g1, g2, z = jnp.split(xc, 3, axis=-1)
    z = g1 * _long_conv(z, k_f[:, 0], hy_bias[0])
    return g2 * _long_conv(z, k_f[:, 1], hy_bias[1])


def _trunk_layer(x, cond, ctx_k, ctx_v, layer_idx, lp):
    bsz, L, _ = x.shape
    alpha = (2.0 * DEPTH) ** 0.25
    mod = jax.nn.silu(cond) @ lp["w_mod"] + lp["b_mod"]
    shift, scale, gate = jnp.split(mod[:, None, :], 3, axis=-1)
    h = _layer_norm(x) * (1.0 + scale) + shift
    (a_u, a_v, a_g, b_x, b_g, c_q, c_k, c_v, c_g,
     d_x1, d_x2, d_v, d_g) = jnp.split(h @ lp["w_in"], N_IN_PIECES, axis=-1)

    y_a = jax.nn.silu(a_g) * _chunk_gmlp(a_u, a_v, lp["gmlp_w"], lp["gmlp_b"])
    y_b = jax.nn.silu(b_g) * _multiscale_pool(b_x, lp["pool_w"], lp["pool_scale"])

    q = c_q.reshape(bsz, L, N_HEADS_C, 2, QK_HALF)
    k = c_k.reshape(bsz, L, N_HEADS_C, 2, QK_HALF)
    v = c_v.reshape(bsz, L, N_HEADS_C, HEAD_DIM_C)
    if ctx_k is None:
        q_att, keys, vals = q, k, v
    else:
        ang_r, ang_c = _axial_angles(L)
        q_att = _axial_rope(q, ang_r, ang_c)
        keys = jnp.concatenate([ctx_k, _axial_rope(k, ang_r, ang_c)], axis=1)
        vals = jnp.concatenate([ctx_v, v], axis=1)
    lam_qk = lp["lambda_qk"].astype(F32)
    lam_init = 0.8 - 0.6 * math.exp(-0.3 * layer_idx)
    lam = jnp.exp(jnp.sum(lam_qk[0] * lam_qk[1])) - jnp.exp(jnp.sum(lam_qk[2] * lam_qk[3])) + lam_init
    y_c = jax.nn.silu(c_g) * _diff_attention(q_att, keys, vals, lam, lam_init, lp["subln_w"])

    k_f = _hyena_filters(L, lp["filt_w1"], lp["filt_b1"], lp["filt_w2"], lp["filt_b2"],
                         lp["filt_freq"], lp["filt_w3"])
    y_d = jax.nn.silu(d_g) * _hyena(d_x1, d_x2, d_v, lp["conv_w"], lp["conv_b"], k_f, lp["hyena_bias"])

    y = jnp.concatenate([y_a, y_b, y_c, y_d], axis=-1) @ lp["w_out"] + lp["b_out"]
    x = _layer_norm(alpha * x + gate * y) * lp["ln_g"] + lp["ln_b"]
    return x, k, v


def setup_inputs(seed: int = 0) -> dict:
    key = jax.random.key(seed)
    ks = jax.random.split(key, 28)

    def nrm(i, shape, s):
        return jax.random.normal(ks[i], shape, F32) * s

    beta = (8.0 * DEPTH) ** -0.25
    return {
        "x_prompt": nrm(0, (BATCH, SEQ, D_MODEL), 1.0),
        "x_sample": nrm(1, (DEC_BATCH, DEC_SEQ, D_MODEL), 1.0),
        "cache_k": nrm(2, (DEC_BATCH, DEPTH, PAST_LEN, N_HEADS_C, 2, QK_HALF), 1.0),
        "cache_v": nrm(3, (DEC_BATCH, DEPTH, PAST_LEN, N_HEADS_C, HEAD_DIM_C), 1.0),
        "c": nrm(4, (DEC_BATCH, D_MODEL), 1.0),
        "c_ctx": nrm(5, (D_MODEL,), 1.0),
        "w_mod": nrm(6, (DEPTH, D_MODEL, 3 * D_MODEL), 0.5 * D_MODEL ** -0.5),
        "b_mod": nrm(7, (DEPTH, 3 * D_MODEL), 0.01),
        "w_in": nrm(8, (DEPTH, D_MODEL, D_IN), D_MODEL ** -0.5),
        "gmlp_w": nrm(9, (DEPTH, N_GROUPS, CHUNK, CHUNK), CHUNK ** -0.5),
        "gmlp_b": 1.0 + nrm(10, (DEPTH, N_GROUPS, CHUNK), 0.01),
        "pool_w": nrm(11, (DEPTH, N_GROUPS, GROUP_W, GROUP_W), GROUP_W ** -0.5),
        "pool_scale": 1.0 + nrm(12, (DEPTH, BRANCH), 0.02),
        "lambda_qk": nrm(13, (DEPTH, 4, QK_HALF), 0.1),
        "subln_w": 1.0 + nrm(14, (DEPTH, HEAD_DIM_C), 0.02),
        "conv_w": nrm(15, (DEPTH, SHORT_CONV, 3 * BRANCH), SHORT_CONV ** -0.5),
        "conv_b": nrm(16, (DEPTH, 3 * BRANCH), 0.01),
        "filt_w1": nrm(17, (DEPTH, HY_EMB, HY_HIDDEN), HY_EMB ** -0.5),
        "filt_b1": nrm(18, (DEPTH, HY_HIDDEN), 0.01),
        "filt_w2": nrm(19, (DEPTH, HY_HIDDEN, HY_HIDDEN), HY_HIDDEN ** -0.5),
        "filt_b2": nrm(20, (DEPTH, HY_HIDDEN), 0.01),
        "filt_freq": 1.0 + nrm(21, (DEPTH, HY_HIDDEN), 0.02),
        "filt_w3": nrm(22, (DEPTH, HY_HIDDEN, HY_ORDER * 2 * BRANCH), HY_HIDDEN ** -0.5),
        "hyena_bias": nrm(23, (DEPTH, HY_ORDER, BRANCH), 0.1),
        "w_out": nrm(24, (DEPTH, D_MIX, D_MODEL), beta * D_MIX ** -0.5),
        "b_out": nrm(25, (DEPTH, D_MODEL), 0.01),
        "ln_g": 1.0 + nrm(26, (DEPTH, D_MODEL), 0.02),
        "ln_b": nrm(27, (DEPTH, D_MODEL), 0.01),
    }


def reference(x_prompt, x_sample, cache_k, cache_v, c, c_ctx, w_mod, b_mod, w_in, gmlp_w, gmlp_b,
              pool_w, pool_scale, lambda_qk, subln_w, conv_w, conv_b, filt_w1, filt_b1, filt_w2,
              filt_b2, filt_freq, filt_w3, hyena_bias, w_out, b_out, ln_g, ln_b):
    xp = x_prompt
    xs = x_sample
    cond_ctx = c_ctx[None, :]
    new_k = []
    new_v = []
    for l in range(DEPTH):
        lp = {
            "w_mod": w_mod[l], "b_mod": b_mod[l], "w_in": w_in[l],
            "gmlp_w": gmlp_w[l], "gmlp_b": gmlp_b[l],
            "pool_w": pool_w[l], "pool_scale": pool_scale[l],
            "lambda_qk": lambda_qk[l], "subln_w": subln_w[l],
            "conv_w": conv_w[l], "conv_b": conv_b[l],
            "filt_w1": filt_w1[l], "filt_b1": filt_b1[l], "filt_w2": filt_w2[l],
            "filt_b2": filt_b2[l], "filt_freq": filt_freq[l], "filt_w3": filt_w3[l],
            "hyena_bias": hyena_bias[l],
            "w_out": w_out[l], "b_out": b_out[l], "ln_g": ln_g[l], "ln_b": ln_b[l],
        }
        xp, k_l, v_l = _trunk_layer(xp, cond_ctx, None, None, l, lp)
        new_k.append(k_l)
        new_v.append(v_l)
        xs, _, _ = _trunk_layer(xs, c, cache_k[:, l], cache_v[:, l], l, lp)
    new_cache_k = jnp.stack(new_k, axis=1)
    new_cache_v = jnp.stack(new_v, axis=1)
    return (xp, xs, new_cache_k, new_cache_v)
```

```cpp
#include <hip/hip_runtime.h>
#include <hip/hip_cooperative_groups.h>
#include <cstdio>
namespace cg = cooperative_groups;

#ifndef COOP
#define COOP 1
#endif

typedef unsigned short u16;
typedef __attribute__((ext_vector_type(8))) short bf16x8;
typedef __attribute__((ext_vector_type(4))) short bf16x4;
typedef __attribute__((ext_vector_type(4))) float f32x4;

#define DEV __device__ __forceinline__

struct Params {
  const float *x_prompt, *x_sample, *cache_k, *cache_v, *c, *c_ctx, *w_mod, *b_mod, *w_in, *gmlp_w, *gmlp_b,
      *pool_w, *pool_scale, *lambda_qk, *subln_w, *conv_w, *conv_b, *filt_w1, *filt_b1, *filt_w2, *filt_b2,
      *filt_freq, *filt_w3, *hyena_bias, *w_out, *b_out, *ln_g, *ln_b;
  float* out;
  char* ws;
};

constexpr int LDS_TEAM = 73728;
constexpr int LDS_MAIN = 2 * LDS_TEAM;
constexpr int LDS_BYTES = LDS_MAIN + 16;
constexpr size_t OFF_WINT = 0;
constexpr size_t OFF_WOUTT = OFF_WINT + 54525952;
constexpr size_t OFF_H = OFF_WOUTT + 16777216;
constexpr size_t OFF_P = OFF_H + 33554432;
constexpr size_t OFF_Y = OFF_P + 109051904;
constexpr size_t OFF_MOD = OFF_Y + 33554432;
constexpr size_t OFF_F0 = OFF_MOD + 245760;
constexpr size_t OFF_F1 = OFF_F0 + 2162688;
constexpr size_t OFF_FN = OFF_F1 + 8454144;
constexpr size_t OFF_ROPE = OFF_FN + 1048576;
constexpr size_t OFF_BAR = OFF_ROPE + 262144;
constexpr size_t OFF_CNT = OFF_BAR + 13824;
constexpr size_t OFF_KC = OFF_BAR + 16384;
constexpr size_t OFF_VC = OFF_KC + 4194304;
constexpr size_t OUT_YS = 8388608;
constexpr size_t OUT_K = 16777216;
constexpr size_t OUT_V = 16777216 + 4194304;

DEV u16 f2bf(float f) {
  unsigned u = __float_as_uint(f);
  u += 0x7fffu + ((u >> 16) & 1u);
  return (u16)(u >> 16);
}
DEV float bf2f(short h) { return __uint_as_float(((unsigned)(u16)h) << 16); }
DEV float silu(float x) { return x / (1.f + __expf(-x)); }
DEV bf16x8 pack8(const float* f) {
  bf16x8 o;
#pragma unroll
  for (int j = 0; j < 8; j++) o[j] = (short)f2bf(f[j]);
  return o;
}
DEV f32x4 mfma16(bf16x8 a, bf16x8 b, f32x4 c) { return __builtin_amdgcn_mfma_f32_16x16x32_bf16(a, b, c, 0, 0, 0); }
DEV bf16x8 tr_read2(unsigned a0, unsigned a1) {
  bf16x4 lo, hi;
  asm volatile("ds_read_b64_tr_b16 %0, %2\n\tds_read_b64_tr_b16 %1, %3\n\ts_waitcnt lgkmcnt(0)"
               : "=&v"(lo), "=&v"(hi)
               : "v"(a0), "v"(a1)
               : "memory");
  bf16x8 r;
  r[0] = lo[0]; r[1] = lo[1]; r[2] = lo[2]; r[3] = lo[3];
  r[4] = hi[0]; r[5] = hi[1]; r[6] = hi[2]; r[7] = hi[3];
  return r;
}
DEV int launder_tid() {
  int t = threadIdx.x & 255;
  asm volatile("" : "+v"(t));
  return t;
}
DEV float wave_sum(float v) {
#pragma unroll
  for (int o = 32; o; o >>= 1) v += __shfl_xor(v, o);
  return v;
}
DEV float block_sum(float v, float* red) {
  v = wave_sum(v);
  __syncthreads();
  if ((threadIdx.x & 63) == 0) red[threadIdx.x >> 6] = v;
  __syncthreads();
  return red[0] + red[1] + red[2] + red[3];
}


#define XB_TMO 128
#define XB_XCNT(j) (256 + 64 * (j))
#define XB_XSUB(j) (1280 + 64 * (j))
#define XB_XGEN(j) (2304 + 64 * (j))
#define XB_TOP 3328
#define XB_TOPGEN 3392
#define XCD_BAR_WORDS 3456
#define XB_SPIN_CAP (1u << 22)
#define LAS __attribute__((address_space(3)))
DEV unsigned xb_ld(unsigned* p) { return __hip_atomic_load(p, __ATOMIC_RELAXED, __HIP_MEMORY_SCOPE_AGENT); }
DEV unsigned xb_add(unsigned* p, unsigned v) { return __hip_atomic_fetch_add(p, v, __ATOMIC_RELAXED, __HIP_MEMORY_SCOPE_AGENT); }
DEV unsigned xb_xcc_id() { return (unsigned)__builtin_amdgcn_s_getreg((3 << 11) | 20) & 0xFu; }
#define XB_SPIN(cond, bar) do { unsigned _sp = 0; while (cond) { __builtin_amdgcn_s_sleep(1); \
    if ((++_sp & 255u) == 0u) { if (xb_ld(&(bar)[XB_TMO])) break; if (_sp > XB_SPIN_CAP) { atomicAdd(&(bar)[XB_TMO], 1u); break; } } } } while (0)
struct XcdBarrier { unsigned* bar; unsigned x; volatile LAS unsigned* st; };
DEV XcdBarrier xcd_barrier_post(unsigned* bar, volatile LAS unsigned* st) {
  XcdBarrier b; b.bar = bar; b.x = xb_xcc_id(); b.st = st;
  if (threadIdx.x == 0) (void)xb_add(&bar[XB_XCNT(b.x)], 1u);
  return b;
}
DEV void xcd_barrier_complete(unsigned* bar, unsigned x, unsigned& nloc, unsigned& nx) {
  const unsigned G = gridDim.x * gridDim.y * gridDim.z;
  unsigned sum, cnt, mine, sp = 0u;
  for (;;) {
    sum = 0u; cnt = 0u; mine = 0u;
#pragma unroll
    for (unsigned j = 0; j < 16; ++j) { const unsigned c = xb_ld(&bar[XB_XCNT(j)]); sum += c; cnt += (c > 0u) ? 1u : 0u; mine = (j == x) ? c : mine; }
    if (sum == G) break;
    __builtin_amdgcn_s_sleep(1);
    if ((++sp & 255u) == 0u) { if (xb_ld(&bar[XB_TMO])) break; if (sp > XB_SPIN_CAP) { atomicAdd(&bar[XB_TMO], 1u); break; } }
  }
  nloc = mine > 0u ? mine : 1u; nx = cnt > 0u ? cnt : 1u;
}
DEV void xcd_barrier(const XcdBarrier& b) {
  asm volatile("s_waitcnt vmcnt(0)" ::: "memory");
  __syncthreads();
  if (threadIdx.x == 0) {
    unsigned* bar = b.bar;
    __builtin_amdgcn_s_waitcnt(0);
    unsigned nloc = b.st[0], nx = b.st[1];
    if (nloc == 0u) { xcd_barrier_complete(bar, b.x, nloc, nx); b.st[0] = nloc; b.st[1] = nx; }
    const unsigned old = xb_add(&bar[XB_XSUB(b.x)], 1u);
    const unsigned gen = old / nloc;
    if (old + 1u == (gen + 1u) * nloc) {
      __builtin_amdgcn_fence(__ATOMIC_RELEASE, "agent");
      asm volatile("s_waitcnt vmcnt(0)" ::: "memory");
      const unsigned og = xb_add(&bar[XB_TOP], 1u);
      const unsigned tg = og / nx;
      if (og + 1u == (tg + 1u) * nx) xb_add(&bar[XB_TOPGEN], 1u);
      else XB_SPIN(xb_ld(&bar[XB_TOPGEN]) == tg, bar);
      __builtin_amdgcn_fence(__ATOMIC_ACQUIRE, "agent");
      xb_add(&bar[XB_XGEN(b.x)], 1u);
      asm volatile("s_waitcnt vmcnt(0)" ::: "memory");
    } else {
      XB_SPIN(xb_ld(&bar[XB_XGEN(b.x)]) == gen, bar);
      __builtin_amdgcn_fence(__ATOMIC_ACQUIRE, "agent");
      asm volatile("s_waitcnt vmcnt(0)" ::: "memory");
    }
  }
  __syncthreads();
}

extern __shared__ __attribute__((aligned(16))) char dyn_smem[];

DEV void p0_transpose(const float* __restrict__ W, u16* __restrict__ WT, int K, int N, int kt, int nt, char* smem) {
  float* sm = (float*)smem;
  const int tid = launder_tid();
  const int k0 = kt * 64, n0 = nt * 256;
  float4 v[16];
#pragma unroll
  for (int i = 0; i < 16; i++) {
    int r = (tid >> 6) + i * 4, c4 = tid & 63;
    v[i] = *(const float4*)(W + (size_t)(k0 + r) * N + n0 + c4 * 4);
  }
#pragma unroll
  for (int i = 0; i < 16; i++) {
    int r = (tid >> 6) + i * 4, c4 = tid & 63;
    float* d = sm + r * 257 + c4 * 4;
    d[0] = v[i].x; d[1] = v[i].y; d[2] = v[i].z; d[3] = v[i].w;
  }
  __syncthreads();
#pragma unroll
  for (int i = 0; i < 8; i++) {
    int ch = tid + i * 256, kc = ch & 7, n = ch >> 3;
    float f[8];
#pragma unroll
    for (int j = 0; j < 8; j++) f[j] = sm[(kc * 8 + j) * 257 + n];
    *(bf16x8*)(WT + (size_t)(n0 + n) * K + k0 + kc * 8) = pack8(f);
  }
  __syncthreads();
}

DEV void p0_mod(const Params& p, int l, int cgp, char* smem) {
  float* s = (float*)smem;
  float* red = s + 10240;
  const int tid = launder_tid();
  for (int i = tid; i < 10240; i += 256) {
    int r = i >> 11, k = i & 2047;
    float cv = (r == 0) ? p.c_ctx[k] : p.c[(r - 1) * 2048 + k];
    s[i] = cv / (1.f + expf(-cv));
  }
  __syncthreads();
  const int cq = tid & 15, ks = tid >> 4;
  const float* W = p.w_mod + (size_t)l * 2048 * 6144 + cgp * 64 + cq * 4;
  float acc[5][4];
#pragma unroll
  for (int r = 0; r < 5; r++)
#pragma unroll
    for (int e = 0; e < 4; e++) acc[r][e] = 0.f;
#pragma unroll 16
  for (int k = ks * 128; k < ks * 128 + 128; k++) {
    float4 w = *(const float4*)(W + (size_t)k * 6144);
#pragma unroll
    for (int r = 0; r < 5; r++) {
      float sv = s[r * 2048 + k];
      acc[r][0] += sv * w.x; acc[r][1] += sv * w.y; acc[r][2] += sv * w.z; acc[r][3] += sv * w.w;
    }
  }
#pragma unroll
  for (int r = 0; r < 5; r++)
#pragma unroll
    for (int e = 0; e < 4; e++) red[(ks * 5 + r) * 64 + cq * 4 + e] = acc[r][e];
  __syncthreads();
  float* MOD = (float*)(p.ws + OFF_MOD);
  for (int i = tid; i < 320; i += 256) {
    int r = i >> 6, col = i & 63;
    float sum = 0.f;
#pragma unroll
    for (int k2 = 0; k2 < 16; k2++) sum += red[(k2 * 5 + r) * 64 + col];
    sum += p.b_mod[l * 6144 + cgp * 64 + col];
    MOD[(l * 5 + r) * 6144 + cgp * 64 + col] = sum;
  }
  __syncthreads();
}

DEV void p0_filter(const Params& p, int l, int path, int chunk, int q, char* smem) {
  const int L = path ? 1024 : 256;
  const int XLEN = 2 * L + 16;
  float* w1s = (float*)smem;
  float* w2s = w1s + 2112;
  float* feats = w2s + 4096;
  float* h1 = feats + 1056;
  float* h2 = h1 + 2048;
  u16* tile = (u16*)smem;
  const int tid = launder_tid();
  const int o = q >> 1, dir = q & 1;
  const float* b1 = p.filt_b1 + l * 64;
  const float* b2 = p.filt_b2 + l * 64;
  const float* fr = p.filt_freq + l * 64;
  const float invLm1 = 1.f / (float)(L - 1);
  __syncthreads();
  for (int i = tid; i < 2112; i += 256) w1s[i] = p.filt_w1[l * 2112 + i];
  for (int i = tid; i < 4096; i += 256) w2s[i] = p.filt_w2[l * 4096 + i];
  for (int e = tid; e < 1056; e += 256) {
    int t = e / 33, f = e - t * 33;
    int tg = chunk * 32 + t;
    float v;
    if (f == 0) v = (float)tg * invLm1;
    else {
      int bb = (f - 1) & 15;
      float band = 1e-4f + (float)bb * ((15.f - 1e-4f) / 15.f);
      float ang = (6.283185307179586f * (float)tg / (float)L) * band;
      v = (f <= 16) ? cosf(ang) : sinf(ang);
    }
    feats[e] = v;
  }
  __syncthreads();
  {
    int t = tid >> 3, j0 = (tid & 7) * 8;
    float a[8];
#pragma unroll
    for (int k = 0; k < 8; k++) a[k] = b1[j0 + k];
#pragma unroll 3
    for (int f = 0; f < 33; f++) {
      float fv = feats[t * 33 + f];
#pragma unroll
      for (int k = 0; k < 8; k++) a[k] += fv * w1s[f * 64 + j0 + k];
    }
#pragma unroll
    for (int k = 0; k < 8; k++) h1[t * 64 + j0 + k] = sinf(fr[j0 + k] * a[k]);
  }
  __syncthreads();
  {
    int t = tid >> 3, j0 = (tid & 7) * 8;
    float a[8];
#pragma unroll
    for (int k = 0; k < 8; k++) a[k] = b2[j0 + k];
#pragma unroll 4
    for (int f = 0; f < 64; f++) {
      float fv = h1[t * 64 + f];
#pragma unroll
      for (int k = 0; k < 8; k++) a[k] += fv * w2s[f * 64 + j0 + k];
    }
#pragma unroll
    for (int k = 0; k < 8; k++) h2[t * 64 + j0 + k] = sinf(fr[j0 + k] * a[k]);
  }
  __syncthreads();
  const float da = logf(1e-2f) / 0.3f, db = logf(1e-2f) / 1.5f;
  float* FNP = (float*)(p.ws + OFF_FN);
#pragma unroll 1
  for (int cc = 0; cc < 2; cc++) {
    const int ch = tid + cc * 256;
    const float* w3 = p.filt_w3 + (size_t)l * 64 * 2048 + q * 512 + ch;
    float w3r[64];
#pragma unroll
    for (int j = 0; j < 64; j++) w3r[j] = w3[j * 2048];
    const float delta = fabsf(da + (db - da) * ((float)ch / 511.f));
    float asum = 0.f;
#pragma unroll 2
    for (int t = 0; t < 32; t++) {
      const int tg = chunk * 32 + t;
      float acc = 0.f;
      const float* hp = h2 + t * 64;
      asm volatile("" : "+v"(hp));
#pragma unroll
      for (int j4 = 0; j4 < 16; j4++) {
        float4 hv = *(const float4*)(hp + j4 * 4);
        acc += hv.x * w3r[j4 * 4] + hv.y * w3r[j4 * 4 + 1] + hv.z * w3r[j4 * 4 + 2] + hv.w * w3r[j4 * 4 + 3];
      }
      float v = acc * expf(-(float)tg * invLm1 * delta);
      if (dir == 0 || tg >= 1) asum += fabsf(v);
      tile[ch * 34 + t] = f2bf(v);
    }
    FNP[((((path * 2 + l) * 4 + q) * 32) + chunk) * 512 + ch] = asum;
  }
  __syncthreads();
  u16* Fb = (u16*)(p.ws + (path ? OFF_F1 : OFF_F0));
  {
    const int hw = tid >> 5, t = tid & 31;
    const int tg = chunk * 32 + t;
    const int x = dir ? L + tg : L - tg;
    const bool ok = (dir == 0) || (tg >= 1);
    for (int ch = hw; ch < 512; ch += 8) {
      if (ok) Fb[((size_t)((l * 2 + o) * 512 + ch)) * XLEN + x] = tile[ch * 34 + t];
    }
  }
  if (chunk == 0) {
    if (dir == 0) {
      for (int ch = tid; ch < 512; ch += 256) Fb[((size_t)((l * 2 + o) * 512 + ch)) * XLEN] = 0;
    } else {
      for (int e = tid; e < 512 * 16; e += 256) Fb[((size_t)((l * 2 + o) * 512 + (e >> 4))) * XLEN + 2 * L + (e & 15)] = 0;
    }
  }
  __syncthreads();
}

DEV void p0_rope(const Params& p, int item) {
  int idx = item * 256 + (threadIdx.x & 255);
  int t = idx >> 5, f = idx & 31;
  int fi = f & 15;
  float inv = powf(10000.f, -(float)(2 * fi) / 32.f);
  float pos = (f < 16) ? (float)(t >> 6) : (float)(t & 63);
  float ang = pos * inv;
  float2 cs;
  cs.x = cosf(ang);
  cs.y = sinf(ang);
  ((float2*)(p.ws + OFF_ROPE))[idx] = cs;
}

DEV void phase_prep(const Params& p, int bid, int nb, char* smem) {
  constexpr int N_MOD = 192, N_FILT = 320, N_TIN = 832, N_TOUT = 256, N_ROPE = 128, N_CVT = 512;
  constexpr int TOT = N_MOD + N_FILT + N_TIN + N_TOUT + N_ROPE + N_CVT;
  const int team = __builtin_amdgcn_readfirstlane(threadIdx.x >> 8);
  smem += team * LDS_TEAM;
  volatile LAS unsigned* stq = (volatile LAS unsigned*)(dyn_smem + LDS_MAIN);
  unsigned* cnt = (unsigned*)(p.ws + OFF_CNT);
  for (;;) {
    __syncthreads();
    if (threadIdx.x == 0) stq[2] = atomicAdd(cnt, 1u);
    __syncthreads();
    const int jp = (int)stq[2];
    if (jp >= TOT / 2) break;
    int i = jp * 2 + team;
    if (i < N_MOD) { p0_mod(p, i / 96, i % 96, smem); continue; }
    i -= N_MOD;
    if (i < N_FILT) {
      if (i < 256) p0_filter(p, i >> 7, 1, (i >> 2) & 31, i & 3, smem);
      else { int k = i - 256; p0_filter(p, k >> 5, 0, (k >> 2) & 7, k & 3, smem); }
      continue;
    }
    i -= N_FILT;
    if (i < N_TIN) {
      int nt = i % 26, kt = i / 26;
      p0_transpose(p.w_in, (u16*)(p.ws + OFF_WINT), 2048, 6656, kt, nt, smem);
      continue;
    }
    i -= N_TIN;
    if (i < N_TOUT) {
      int nt = i % 8, kt = i / 8;
      p0_transpose(p.w_out, (u16*)(p.ws + OFF_WOUTT), 2048, 2048, kt, nt, smem);
      continue;
    }
    i -= N_TOUT;
    if (i < N_ROPE) { p0_rope(p, i); continue; }
    i -= N_ROPE;
    {
      const float* src = (i < 256) ? p.cache_k : p.cache_v;
      u16* dst = (u16*)(p.ws + ((i < 256) ? OFF_KC : OFF_VC));
      const int tl = threadIdx.x & 255;
      const size_t base = (size_t)(i & 255) * 8192;
#pragma unroll
      for (int e = 0; e < 4; e++) {
        const size_t o = base + (size_t)(e * 256 + tl) * 8;
        float4 a = *(const float4*)(src + o), c2 = *(const float4*)(src + o + 4);
        float f[8] = {a.x, a.y, a.z, a.w, c2.x, c2.y, c2.z, c2.w};
        *(bf16x8*)(dst + o) = pack8(f);
      }
    }
  }
}

DEV void phase_rows(const Params& p, int mode, int l, int bid, int nb, char* smem) {
  const int lane = threadIdx.x & 63, wave = threadIdx.x >> 6;
  const float* MOD = (const float*)(p.ws + OFF_MOD);
  const float* PRE = (const float*)(p.ws + OFF_P);
  u16* H = (u16*)(p.ws + OFF_H);
  for (int row = bid * 8 + wave; row < 8192; row += nb * 8) {
    const float* src;
    if (mode == 0) src = (row < 4096) ? p.x_prompt + (size_t)row * 2048 : p.x_sample + (size_t)(row - 4096) * 2048;
    else src = PRE + (size_t)row * 2048;
    float4 v[8];
#pragma unroll
    for (int k = 0; k < 8; k++) v[k] = *(const float4*)(src + k * 256 + lane * 4);
    if (mode != 0) {
      const int lp = (mode == 1) ? l - 1 : 1;
      float s = 0.f;
#pragma unroll
      for (int k = 0; k < 8; k++) s += v[k].x + v[k].y + v[k].z + v[k].w;
      const float mean = wave_sum(s) * (1.f / 2048.f);
      float q = 0.f;
#pragma unroll
      for (int k = 0; k < 8; k++) {
        v[k].x -= mean; v[k].y -= mean; v[k].z -= mean; v[k].w -= mean;
        q += v[k].x * v[k].x + v[k].y * v[k].y + v[k].z * v[k].z + v[k].w * v[k].w;
      }
      const float rstd = rsqrtf(wave_sum(q) * (1.f / 2048.f) + 1e-6f);
      const float* g = p.ln_g + lp * 2048;
      const float* bb = p.ln_b + lp * 2048;
#pragma unroll
      for (int k = 0; k < 8; k++) {
        const int c0 = k * 256 + lane * 4;
        float4 g4 = *(const float4*)(g + c0), b4 = *(const float4*)(bb + c0);
        v[k].x = v[k].x * rstd * g4.x + b4.x; v[k].y = v[k].y * rstd * g4.y + b4.y;
        v[k].z = v[k].z * rstd * g4.z + b4.z; v[k].w = v[k].w * rstd * g4.w + b4.w;
        *(float4*)(p.out + (size_t)row * 2048 + c0) = v[k];
      }
      if (mode == 2) continue;
    }
    float s = 0.f;
#pragma unroll
    for (int k = 0; k < 8; k++) s += v[k].x + v[k].y + v[k].z + v[k].w;
    const float mean = wave_sum(s) * (1.f / 2048.f);
    float q = 0.f;
#pragma unroll
    for (int k = 0; k < 8; k++) {
      v[k].x -= mean; v[k].y -= mean; v[k].z -= mean; v[k].w -= mean;
      q += v[k].x * v[k].x + v[k].y * v[k].y + v[k].z * v[k].z + v[k].w * v[k].w;
    }
    const float rstd = rsqrtf(wave_sum(q) * (1.f / 2048.f) + 1e-6f);
    const int r = row < 4096 ? 0 : 1 + ((row - 4096) >> 10);
    const float* md = MOD + (l * 5 + r) * 6144;
#pragma unroll
    for (int k = 0; k < 8; k++) {
      const int c0 = k * 256 + lane * 4;
      float4 sh = *(const float4*)(md + c0), sc = *(const float4*)(md + 2048 + c0);
      bf16x4 o;
      o[0] = (short)f2bf(v[k].x * rstd * (1.f + sc.x) + sh.x);
      o[1] = (short)f2bf(v[k].y * rstd * (1.f + sc.y) + sh.y);
      o[2] = (short)f2bf(v[k].z * rstd * (1.f + sc.z) + sh.z);
      o[3] = (short)f2bf(v[k].w * rstd * (1.f + sc.w) + sh.w);
      *(bf16x4*)(H + (size_t)row * 2048 + c0) = o;
    }
  }
}

#ifndef REP_ML
#define REP_ML 1
#endif
DEV int lds_byte(int r, int c) {
  int st = (r >> 4) * 2 + (c >> 5), rr = r & 15, cc = c & 31, ob = rr * 64 + cc * 2;
  return st * 1024 + (ob ^ (((ob >> 9) & 1) << 5));
}
DEV void stage_rc(int b, int& R, int& C) {
  int st = b >> 10, sb = b & 1023, swz = sb ^ (((sb >> 9) & 1) << 5);
  R = (st >> 1) * 16 + (swz >> 6);
  C = (st & 1) * 32 + ((swz & 63) >> 1);
}
constexpr int STG = 49152;
template <int MODE>
DEV void gemm_tile(const Params& p, int l, int tm, int tn, char* smem) {
  int tid = threadIdx.x;
  asm volatile("" : "+v"(tid));
  const int lane = tid & 63, wave = tid >> 6, l15 = lane & 15, quad = lane >> 4;
  const int wm = wave >> 1, wn = wave & 1;
  constexpr int N = (MODE == 1) ? 6656 : 2048;
  const u16* A = (const u16*)(p.ws + (MODE == 1 ? OFF_H : OFF_Y));
  const u16* B = (const u16*)(p.ws + (MODE == 1 ? OFF_WINT : OFF_WOUTT)) + (size_t)l * N * 2048;
  const int m0 = tm * 256, n0 = tn * 128;
  int R0, C0, R1, C1;
  stage_rc(tid * 16, R0, C0);
  stage_rc(tid * 16 + 8192, R1, C1);
  const u16* gA0 = A + (size_t)(m0 + R0) * 2048 + C0;
  const u16* gA1 = A + (size_t)(m0 + R1) * 2048 + C1;
  const u16* gB0 = B + (size_t)(n0 + R0) * 2048 + C0;
  const u16* gB1 = B + (size_t)(n0 + R1) * 2048 + C1;
  char* lbase = smem + tid * 16;
  auto issue = [&](int kt, int st) {
    char* d = lbase + st * STG;
    const int ko = kt * 64;
    __builtin_amdgcn_global_load_lds((const unsigned*)(gA0 + ko), (__attribute__((address_space(3))) unsigned*)(d), 16, 0, 0);
    __builtin_amdgcn_global_load_lds((const unsigned*)(gA1 + ko), (__attribute__((address_space(3))) unsigned*)(d + 8192), 16, 0, 0);
    __builtin_amdgcn_global_load_lds((const unsigned*)(gA0 + 128 * 2048 + ko), (__attribute__((address_space(3))) unsigned*)(d + 16384), 16, 0, 0);
    __builtin_amdgcn_global_load_lds((const unsigned*)(gA1 + 128 * 2048 + ko), (__attribute__((address_space(3))) unsigned*)(d + 16384 + 8192), 16, 0, 0);
    __builtin_amdgcn_global_load_lds((const unsigned*)(gB0 + ko), (__attribute__((address_space(3))) unsigned*)(d + 32768), 16, 0, 0);
    __builtin_amdgcn_global_load_lds((const unsigned*)(gB1 + ko), (__attribute__((address_space(3))) unsigned*)(d + 32768 + 8192), 16, 0, 0);
  };
  int aoff[2][4], boff[2][4];
#pragma unroll
  for (int ks = 0; ks < 2; ks++)
#pragma unroll
    for (int i = 0; i < 4; i++) {
      aoff[ks][i] = (wm >> 1) * 16384 + lds_byte((wm & 1) * 64 + i * 16 + l15, ks * 32 + quad * 8);
      boff[ks][i] = 32768 + lds_byte(wn * 64 + i * 16 + l15, ks * 32 + quad * 8);
    }
  f32x4 acc[4][4];
#pragma unroll 1
  for (int rep = 0; rep < REP_ML; rep++) {
#pragma unroll
    for (int i = 0; i < 4; i++)
#pragma unroll
      for (int j = 0; j < 4; j++) acc[i][j] = (f32x4){0.f, 0.f, 0.f, 0.f};
    issue(0, 0);
    issue(1, 1);
    int st = 0;
#pragma unroll 1
    for (int kt = 0; kt < 32; kt++) {
      if (kt < 31) asm volatile("s_waitcnt vmcnt(6)" ::: "memory");
      else asm volatile("s_waitcnt vmcnt(0)" ::: "memory");
      __builtin_amdgcn_s_barrier();
      if (kt + 2 < 32) issue(kt + 2, st >= 1 ? st - 1 : 2);
      const char* sb = smem + st * STG;
#pragma unroll
      for (int ks = 0; ks < 2; ks++) {
        bf16x8 af[4], bfr[4];
#pragma unroll
        for (int i = 0; i < 4; i++) {
          af[i] = *(const bf16x8*)(sb + aoff[ks][i]);
          bfr[i] = *(const bf16x8*)(sb + boff[ks][i]);
        }
#pragma unroll
        for (int mt = 0; mt < 4; mt++)
#pragma unroll
          for (int nt = 0; nt < 4; nt++) acc[mt][nt] = mfma16(af[mt], bfr[nt], acc[mt][nt]);
      }
      st = st == 2 ? 0 : st + 1;
    }
    __builtin_amdgcn_s_barrier();
  }
  float* Cw = (float*)(smem + wave * 17408);
  const int rr = lane >> 3, c8 = (lane & 7) * 8;
  if (MODE == 1) {
    u16* P = (u16*)(p.ws + OFF_P);
    const int piece = n0 >> 9;
    const bool latent = m0 >= 4096;
    const float2* ROPE = (const float2*)(p.ws + OFF_ROPE);
#pragma unroll
    for (int mt = 0; mt < 4; mt++)
#pragma unroll
      for (int j = 0; j < 4; j++) {
        const int lr = mt * 16 + quad * 4 + j;
        float v0 = acc[mt][0][j], v1 = acc[mt][1][j], v2 = acc[mt][2][j], v3 = acc[mt][3][j];
        if (latent && (piece == 5 || piece == 6)) {
          const int t = (m0 + wm * 64 + lr - 4096) & 1023;
          float2 cr = ROPE[t * 32 + l15], cc = ROPE[t * 32 + 16 + l15];
          float a0 = v0 * cr.x - v1 * cr.y, a1 = v1 * cr.x + v0 * cr.y;
          float a2 = v2 * cc.x - v3 * cc.y, a3 = v3 * cc.x + v2 * cc.y;
          v0 = a0; v1 = a1; v2 = a2; v3 = a3;
        }
        float* cw = Cw + lr * 68 + l15;
        cw[0] = v0; cw[16] = v1; cw[32] = v2; cw[48] = v3;
      }
    const bool kvout = !latent && (piece == 6 || piece == 7);
#pragma unroll
    for (int ps = 0; ps < 8; ps++) {
      const int lr = ps * 8 + rr;
      const int row = m0 + wm * 64 + lr;
      const int col = n0 + wn * 64 + c8;
      float4 a = *(const float4*)(Cw + lr * 68 + c8), b4 = *(const float4*)(Cw + lr * 68 + c8 + 4);
      float f[8] = {a.x, a.y, a.z, a.w, b4.x, b4.y, b4.z, b4.w};
      *(bf16x8*)(P + (size_t)row * 6656 + col) = pack8(f);
      if (kvout) {
        const int bb = row >> 8, t = row & 255;
        float* o = p.out + (piece == 6 ? OUT_K : OUT_V) + ((size_t)((bb * 2 + l) * 256 + t)) * 512 + (col - piece * 512);
        *(float4*)o = a;
        *(float4*)(o + 4) = b4;
      }
    }
  } else {
    float* PRE = (float*)(p.ws + OFF_P);
    const float* MOD = (const float*)(p.ws + OFF_MOD);
    const float alpha = 1.41421356237f;
#pragma unroll
    for (int mt = 0; mt < 4; mt++)
#pragma unroll
      for (int j = 0; j < 4; j++) {
        float* cw = Cw + (mt * 16 + quad * 4 + j) * 68 + l15;
        cw[0] = acc[mt][0][j]; cw[16] = acc[mt][1][j]; cw[32] = acc[mt][2][j]; cw[48] = acc[mt][3][j];
      }
#pragma unroll
    for (int ps = 0; ps < 8; ps++) {
      const int lr = ps * 8 + rr;
      const int row = m0 + wm * 64 + lr;
      const int col = n0 + wn * 64 + c8;
      const int r = row < 4096 ? 0 : 1 + ((row - 4096) >> 10);
      const float* gate = MOD + (l * 5 + r) * 6144 + 4096 + col;
      const float* xr = ((l == 0) ? ((row < 4096) ? p.x_prompt + (size_t)row * 2048 : p.x_sample + (size_t)(row - 4096) * 2048)
                                  : p.out + (size_t)row * 2048) + col;
      const float* bo = p.b_out + l * 2048 + col;
      float* dst = PRE + (size_t)row * 2048 + col;
#pragma unroll
      for (int hh = 0; hh < 2; hh++) {
        float4 a = *(const float4*)(Cw + lr * 68 + c8 + hh * 4);
        float4 x4 = *(const float4*)(xr + hh * 4), g4 = *(const float4*)(gate + hh * 4), b4 = *(const float4*)(bo + hh * 4);
        float4 o4;
        o4.x = alpha * x4.x + g4.x * (a.x + b4.x);
        o4.y = alpha * x4.y + g4.y * (a.y + b4.y);
        o4.z = alpha * x4.z + g4.z * (a.z + b4.z);
        o4.w = alpha * x4.w + g4.w * (a.w + b4.w);
        *(float4*)(dst + hh * 4) = o4;
      }
    }
  }
  __builtin_amdgcn_s_waitcnt(0xc07f);
  __builtin_amdgcn_s_barrier();
}

template <int MODE>
DEV void phase_gemm(const Params& p, int l, int bid, int nb, char* smem) {
  constexpr int NT = (MODE == 1) ? 52 : 16;
  for (int t = bid; t < 32 * NT; t += nb) gemm_tile<MODE>(p, l, t & 31, t >> 5, smem);
}

DEV void mm128(const char* Al, const char* Bl, f32x4 (&acc)[2][8], int wave, int lane) {
  const int l15 = lane & 15, quad = lane >> 4, q4 = l15 >> 2, p4 = lane & 3;
  const unsigned bbase = (unsigned)(size_t)Bl + (quad * 8 + q4) * 288 + p4 * 8;
#pragma unroll
  for (int ks = 0; ks < 4; ks++) {
    bf16x8 a[2];
#pragma unroll
    for (int mt = 0; mt < 2; mt++) a[mt] = *(const bf16x8*)(Al + (wave * 32 + mt * 16 + l15) * 272 + ks * 64 + quad * 16);
#pragma unroll
    for (int nt = 0; nt < 8; nt++) {
      bf16x8 b = tr_read2(bbase + ks * 32 * 288 + nt * 32, bbase + ks * 32 * 288 + 4 * 288 + nt * 32);
#pragma unroll
      for (int mt = 0; mt < 2; mt++) acc[mt][nt] = mfma16(a[mt], b, acc[mt][nt]);
    }
  }
}

DEV void load_f32_tile_bf16(const float* src, char* dst, int stride_bytes) {
  const int tid = launder_tid();
#pragma unroll
  for (int i = 0; i < 8; i++) {
    int idx = tid + 256 * i, r = idx >> 4, c8 = idx & 15;
    float4 a = *(const float4*)(src + r * 128 + c8 * 8), b = *(const float4*)(src + r * 128 + c8 * 8 + 4);
    float f[8] = {a.x, a.y, a.z, a.w, b.x, b.y, b.z, b.w};
    *(bf16x8*)(dst + r * stride_bytes + c8 * 16) = pack8(f);
  }
}

DEV void gmlp_item(const Params& p, int l, int chunk, int g, char* smem) {
  char* Al = smem;
  char* Bl = smem + 34816;
  const int tid = launder_tid(), lane = tid & 63, wave = tid >> 6, l15 = lane & 15, quad = lane >> 4;
  const u16* P = (const u16*)(p.ws + OFF_P);
  u16* Y = (u16*)(p.ws + OFF_Y);
  const int r0 = chunk * 128;
  load_f32_tile_bf16(p.gmlp_w + (size_t)(l * 4 + g) * 16384, Al, 272);
#pragma unroll 1
  for (int rb = 0; rb < 4; rb++) {
    bf16x8 vv[8];
#pragma unroll
    for (int k = 0; k < 8; k++) vv[k] = *(const bf16x8*)(P + (size_t)(r0 + wave * 32 + rb * 8 + k) * 6656 + 512 + lane * 8);
#pragma unroll
    for (int k = 0; k < 8; k++) {
      const int j = wave * 32 + rb * 8 + k;
      float f[8];
      float sm1 = 0.f;
#pragma unroll
      for (int e = 0; e < 8; e++) { f[e] = bf2f(vv[k][e]); sm1 += f[e]; }
      const float mean = wave_sum(sm1) * (1.f / 512.f);
      float q = 0.f;
#pragma unroll
      for (int e = 0; e < 8; e++) { f[e] -= mean; q += f[e] * f[e]; }
      const float rstd = rsqrtf(wave_sum(q) * (1.f / 512.f) + 1e-6f);
      if (quad == g) {
#pragma unroll
        for (int e = 0; e < 8; e++) f[e] *= rstd;
        *(bf16x8*)(Bl + j * 288 + l15 * 16) = pack8(f);
      }
    }
  }
  __syncthreads();
  f32x4 acc[2][8];
#pragma unroll
  for (int i = 0; i < 2; i++)
#pragma unroll
    for (int j = 0; j < 8; j++) acc[i][j] = (f32x4){0.f, 0.f, 0.f, 0.f};
  mm128(Al, Bl, acc, wave, lane);
  __syncthreads();
  float* Ct = (float*)smem + wave * 32 * 132;
#pragma unroll
  for (int mt = 0; mt < 2; mt++)
#pragma unroll
    for (int nt = 0; nt < 8; nt++)
#pragma unroll
      for (int j = 0; j < 4; j++) Ct[(mt * 16 + quad * 4 + j) * 132 + nt * 16 + l15] = acc[mt][nt][j];
#pragma unroll 2
  for (int k = 0; k < 8; k++) {
    const int id = lane + 64 * k, r = id >> 4, c8 = (id & 15) * 8;
    const int i = wave * 32 + r;
    const float bs = p.gmlp_b[(l * 4 + g) * 128 + i];
    const u16* pr = P + (size_t)(r0 + i) * 6656 + g * 128 + c8;
    bf16x8 uv = *(const bf16x8*)pr;
    bf16x8 gv = *(const bf16x8*)(pr + 1024);
    float4 a0 = *(const float4*)(Ct + r * 132 + c8), a1 = *(const float4*)(Ct + r * 132 + c8 + 4);
    float av[8] = {a0.x, a0.y, a0.z, a0.w, a1.x, a1.y, a1.z, a1.w};
    float f[8];
#pragma unroll
    for (int e = 0; e < 8; e++) f[e] = silu(bf2f(gv[e])) * bf2f(uv[e]) * (av[e] + bs);
    *(bf16x8*)(Y + (size_t)(r0 + i) * 2048 + g * 128 + c8) = pack8(f);
  }
  __syncthreads();
}

DEV void pool_item(const Params& p, int l, int tile, int g, char* smem) {
  char* Sl = smem;
  char* Al = smem + 36864;
  const int tid = launder_tid(), lane = tid & 63, wave = tid >> 6, l15 = lane & 15, quad = lane >> 4;
  const u16* P = (const u16*)(p.ws + OFF_P);
  u16* Y = (u16*)(p.ws + OFF_Y);
  const int r0 = tile * 128;
  int s0, L;
  if (r0 < 4096) { s0 = r0 & ~255; L = 256; } else { s0 = 4096 + ((r0 - 4096) & ~1023); L = 1024; }
  const int w2 = 1 << g;
  for (int idx = tid; idx < 144 * 16; idx += 256) {
    int rr = idx >> 4, c8 = idx & 15;
    int row = r0 - 8 + rr;
    bf16x8 v = (bf16x8){0, 0, 0, 0, 0, 0, 0, 0};
    if (row >= s0 && row < s0 + L) v = *(const bf16x8*)(P + (size_t)row * 6656 + 3 * 512 + g * 128 + c8 * 8);
    *(bf16x8*)(Sl + rr * 256 + c8 * 16) = v;
  }
  __syncthreads();
#pragma unroll 1
  for (int i = 0; i < 8; i++) {
    int idx = tid + 256 * i, t = idx >> 4, c8 = idx & 15;
    int tl = r0 + t - s0;
    int lo = max(tl - w2, 0), hi = min(tl + w2, L);
    float s[8];
#pragma unroll
    for (int e = 0; e < 8; e++) s[e] = 0.f;
    for (int u = lo; u < hi; u++) {
      bf16x8 v = *(const bf16x8*)(Sl + (u - tl + t + 8) * 256 + c8 * 16);
#pragma unroll
      for (int e = 0; e < 8; e++) s[e] += bf2f(v[e]);
    }
    const float inv = 1.f / (float)(hi - lo);
    bf16x8 cv = *(const bf16x8*)(Sl + (t + 8) * 256 + c8 * 16);
#pragma unroll
    for (int e = 0; e < 8; e++) s[e] = s[e] * inv - bf2f(cv[e]);
    *(bf16x8*)(Al + t * 272 + c8 * 16) = pack8(s);
  }
  __syncthreads();
  load_f32_tile_bf16(p.pool_w + (size_t)(l * 4 + g) * 16384, Sl, 288);
  __syncthreads();
  f32x4 acc[2][8];
#pragma unroll
  for (int i = 0; i < 2; i++)
#pragma unroll
    for (int j = 0; j < 8; j++) acc[i][j] = (f32x4){0.f, 0.f, 0.f, 0.f};
  mm128(Al, Sl, acc, wave, lane);
  __syncthreads();
  float* Ct = (float*)smem + wave * 32 * 132;
#pragma unroll
  for (int mt = 0; mt < 2; mt++)
#pragma unroll
    for (int nt = 0; nt < 8; nt++)
#pragma unroll
      for (int j = 0; j < 4; j++) Ct[(mt * 16 + quad * 4 + j) * 132 + nt * 16 + l15] = acc[mt][nt][j];
#pragma unroll 2
  for (int k = 0; k < 8; k++) {
    const int id = lane + 64 * k, r = id >> 4, c8 = (id & 15) * 8;
    const int row = r0 + wave * 32 + r;
    bf16x8 gv = *(const bf16x8*)(P + (size_t)row * 6656 + 4 * 512 + g * 128 + c8);
    const float* psc = p.pool_scale + l * 512 + g * 128 + c8;
    float4 s0 = *(const float4*)psc, s1 = *(const float4*)(psc + 4);
    float sv[8] = {s0.x, s0.y, s0.z, s0.w, s1.x, s1.y, s1.z, s1.w};
    float4 a0 = *(const float4*)(Ct + r * 132 + c8), a1 = *(const float4*)(Ct + r * 132 + c8 + 4);
    float av[8] = {a0.x, a0.y, a0.z, a0.w, a1.x, a1.y, a1.z, a1.w};
    float f[8];
#pragma unroll
    for (int e = 0; e < 8; e++) f[e] = av[e] * sv[e] * silu(bf2f(gv[e]));
    *(bf16x8*)(Y + (size_t)row * 2048 + 512 + g * 128 + c8) = pack8(f);
  }
  __syncthreads();
}

DEV void attn_item(const Params& p, int l, int path, int b, int h, int qb, char* smem) {
  char* Kl = smem;
  char* Vl = smem + 17408;
  float* Ol = (float*)smem;
  const int tid = launder_tid(), lane = tid & 63, wave = tid >> 6, l15 = lane & 15, quad = lane >> 4;
  const int q4 = l15 >> 2, p4 = lane & 3;
  const u16* P = (const u16*)(p.ws + OFF_P);
  u16* Y = (u16*)(p.ws + OFF_Y);
  const int rowbase = path ? 4096 + b * 1024 : b * 256;
  const int nkeys = path ? 1536 : 256;
  const int ncache = path ? 512 : 0;
  const float* lq = p.lambda_qk + l * 256;
  const float d01 = wave_sum(lq[lane] * lq[64 + lane]);
  const float d23 = wave_sum(lq[128 + lane] * lq[192 + lane]);
  const float lam_init = 0.8f - 0.6f * expf(-0.3f * (float)l);
  const float lam = expf(d01) - expf(d23) + lam_init;
  bf16x8 qf[2][2];
  {
    const int qrow = rowbase + qb * 64 + wave * 16 + l15;
#pragma unroll
    for (int m = 0; m < 2; m++)
#pragma unroll
      for (int ks = 0; ks < 2; ks++) {
        bf16x8 v = *(const bf16x8*)(P + (size_t)qrow * 6656 + 5 * 512 + h * 128 + m * 64 + ks * 32 + quad * 8);
#pragma unroll
        for (int e = 0; e < 8; e++) v[e] = (short)f2bf(bf2f(v[e]) * 0.125f);
        qf[m][ks] = v;
      }
  }
  f32x4 o[2][8];
#pragma unroll
  for (int m = 0; m < 2; m++)
#pragma unroll
    for (int dt = 0; dt < 8; dt++) o[m][dt] = (f32x4){0.f, 0.f, 0.f, 0.f};
  float mrun[2] = {-1e30f, -1e30f}, lrun[2] = {0.f, 0.f};
  const unsigned vbase = (unsigned)(size_t)Vl + (quad * 4 + q4) * 288 + p4 * 8;
  const u16* KC = (const u16*)(p.ws + OFF_KC);
  const u16* VC = (const u16*)(p.ws + OFF_VC);
  const int ntile = nkeys >> 6;
  bf16x8 rk[4], rv[4];
  auto gload = [&](int t) {
    const int kt0 = t * 64;
#pragma unroll
    for (int i = 0; i < 4; i++) {
      const int chunk = tid + 256 * i, key = chunk >> 4, dc = chunk & 15;
      const int kg = kt0 + key;
      if (kt0 < ncache) {
        const size_t off = (((size_t)b * 2 + l) * 512 + kg) * 512 + h * 128 + dc * 8;
        rk[i] = *(const bf16x8*)(KC + off);
        rv[i] = *(const bf16x8*)(VC + off);
      } else {
        const size_t row = rowbase + (kg - ncache);
        rk[i] = *(const bf16x8*)(P + row * 6656 + 6 * 512 + h * 128 + dc * 8);
        rv[i] = *(const bf16x8*)(P + row * 6656 + 7 * 512 + h * 128 + dc * 8);
      }
    }
  };
  auto lstore = [&](int st) {
#pragma unroll
    for (int i = 0; i < 4; i++) {
      const int chunk = tid + 256 * i, key = chunk >> 4, dc = chunk & 15;
      *(bf16x8*)(Kl + st * 35840 + key * 272 + dc * 16) = rk[i];
      *(bf16x8*)(Vl + st * 35840 + key * 288 + dc * 16) = rv[i];
    }
  };
  __syncthreads();
  gload(0);
  lstore(0);
  if (ntile > 1) gload(1);
  __syncthreads();
#pragma unroll 1
  for (int t = 0; t < ntile; t++) {
    const int stg = t & 1;
    const char* Kc = Kl + stg * 35840;
    const unsigned vb = vbase + stg * 35840;
    if (t + 1 < ntile) {
      lstore(stg ^ 1);
      if (t + 2 < ntile) gload(t + 2);
    }
    __builtin_amdgcn_sched_barrier(0);
    f32x4 s[2][4];
#pragma unroll
    for (int m = 0; m < 2; m++)
#pragma unroll
      for (int kt = 0; kt < 4; kt++) {
        f32x4 a4 = (f32x4){0.f, 0.f, 0.f, 0.f};
#pragma unroll
        for (int ks = 0; ks < 2; ks++) {
          bf16x8 a = *(const bf16x8*)(Kc + (kt * 16 + l15) * 272 + m * 128 + ks * 64 + quad * 16);
          a4 = mfma16(a, qf[m][ks], a4);
        }
        s[m][kt] = a4;
      }
    bf16x8 pf[2][2];
#pragma unroll
    for (int m = 0; m < 2; m++) {
      float tmax = -1e30f;
#pragma unroll
      for (int kt = 0; kt < 4; kt++)
#pragma unroll
        for (int j = 0; j < 4; j++) tmax = fmaxf(tmax, s[m][kt][j]);
      tmax = fmaxf(tmax, __shfl_xor(tmax, 16));
      tmax = fmaxf(tmax, __shfl_xor(tmax, 32));
      const float mnew = fmaxf(mrun[m], tmax);
      const float alpha = __expf(mrun[m] - mnew);
      mrun[m] = mnew;
      float psum = 0.f;
#pragma unroll
      for (int kt = 0; kt < 4; kt++)
#pragma unroll
        for (int j = 0; j < 4; j++) {
          float pv = __expf(s[m][kt][j] - mnew);
          psum += pv;
          s[m][kt][j] = pv;
        }
      lrun[m] = lrun[m] * alpha + psum;
#pragma unroll
      for (int dt = 0; dt < 8; dt++) {
        o[m][dt][0] *= alpha; o[m][dt][1] *= alpha; o[m][dt][2] *= alpha; o[m][dt][3] *= alpha;
      }
#pragma unroll
      for (int kk = 0; kk < 2; kk++) {
        bf16x8 t;
#pragma unroll
        for (int j = 0; j < 4; j++) {
          t[j] = (short)f2bf(s[m][2 * kk][j]);
          t[4 + j] = (short)f2bf(s[m][2 * kk + 1][j]);
        }
        pf[m][kk] = t;
      }
    }
#pragma unroll
    for (int kk = 0; kk < 2; kk++)
#pragma unroll
      for (int dt = 0; dt < 8; dt++) {
        bf16x8 a = tr_read2(vb + (2 * kk) * 16 * 288 + dt * 32, vb + (2 * kk + 1) * 16 * 288 + dt * 32);
        o[0][dt] = mfma16(a, pf[0][kk], o[0][dt]);
        o[1][dt] = mfma16(a, pf[1][kk], o[1][dt]);
        if (dt & 1) __builtin_amdgcn_sched_barrier(0);
      }
    __syncthreads();
  }
  float l0 = lrun[0], l1 = lrun[1];
  l0 += __shfl_xor(l0, 16); l0 += __shfl_xor(l0, 32);
  l1 += __shfl_xor(l1, 16); l1 += __shfl_xor(l1, 32);
  const float i0 = 1.f / l0, i1 = lam / l1;
  float ss = 0.f;
#pragma unroll
  for (int dt = 0; dt < 8; dt++)
#pragma unroll
    for (int j = 0; j < 4; j++) {
      float v = o[0][dt][j] * i0 - o[1][dt][j] * i1;
      o[0][dt][j] = v;
      ss += v * v;
    }
  ss += __shfl_xor(ss, 16);
  ss += __shfl_xor(ss, 32);
  const float sc = rsqrtf(ss * (1.f / 128.f) + 1e-5f) * (1.f - lam_init);
  __syncthreads();
#pragma unroll
  for (int dt = 0; dt < 8; dt++)
#pragma unroll
    for (int j = 0; j < 4; j++) Ol[(wave * 16 + l15) * 132 + dt * 16 + quad * 4 + j] = o[0][dt][j] * sc;
  __syncthreads();
#pragma unroll
  for (int i = 0; i < 4; i++) {
    const int idx = tid + 256 * i, qr = idx >> 4, dc = idx & 15;
    const size_t row = rowbase + qb * 64 + qr;
    bf16x8 gv = *(const bf16x8*)(P + row * 6656 + 8 * 512 + h * 128 + dc * 8);
    float f[8];
#pragma unroll
    for (int e = 0; e < 8; e++) f[e] = Ol[qr * 132 + dc * 8 + e] * p.subln_w[l * 128 + dc * 8 + e] * silu(bf2f(gv[e]));
    *(bf16x8*)(Y + row * 2048 + 1024 + h * 128 + dc * 8) = pack8(f);
  }
  __syncthreads();
}

template <int L, int CG>
DEV void hyena_item(const Params& p, int l, int path, int b, int cgi, char* smem) {
  constexpr int ZLEN = L + 512;
  constexpr int XLEN = 2 * L + 16;
  constexpr int FBL = 2 * L + 32;
  constexpr int NG = L / 256;
  constexpr int NCH = CG / 8;
  u16* zb = (u16*)smem;
  u16* g1b = zb + CG * ZLEN;
  u16* fball = g1b + CG * L;
  const int tid = launder_tid(), lane = tid & 63, wave = tid >> 6, l15 = lane & 15, quad = lane >> 4;
  const u16* P = (const u16*)(p.ws + OFF_P);
  u16* Y = (u16*)(p.ws + OFF_Y);
  const int rowbase = path ? 4096 + b * 1024 : b * 256;
  const int c0 = cgi * CG;
  const float* cw = p.conv_w + l * 3 * 1536;
  const float* cb = p.conv_b + l * 1536;
  __syncthreads();
  for (int i = tid; i < CG * 512; i += 256) {
    int c = i >> 9, x = i & 511;
    zb[c * ZLEN + (x < 256 ? x : L + x)] = 0;
  }
  if (lane < 16) fball[wave * FBL + lane] = 0;
  constexpr int NREG = (XLEN / 8 + 63) / 64;
  constexpr int NQ = (CG / 4) * 2;
  const u16* Fg = (const u16*)(p.ws + (path ? OFF_F1 : OFF_F0));
  const float* FN = (const float*)(p.ws + OFF_FN);
  bf16x8 fr[NREG];
  float nrm_pf = 0.f, bias_pf = 0.f;
  auto fetch_filter = [&](int q) {
    const int chq = c0 + wave + 4 * (q >> 1), oq = q & 1;
    const u16* R = Fg + ((size_t)((l * 2 + oq) * 512 + chq)) * XLEN;
#pragma unroll
    for (int k = 0; k < NREG; k++) {
      const int i = lane + 64 * k;
      if (i < XLEN / 8) fr[k] = *(const bf16x8*)(R + i * 8);
    }
    nrm_pf = 0.f;
    if (lane < 2 * (L / 32)) nrm_pf = FN[((((path * 2 + l) * 4 + oq * 2 + (lane & 1)) * 32) + (lane >> 1)) * 512 + chq];
    bias_pf = p.hyena_bias[(l * 2 + oq) * 512 + chq];
  };
  fetch_filter(0);
#pragma unroll 2
  for (int idx = tid; idx < L * NCH; idx += 256) {
    const int t = idx / NCH, cc = idx - t * NCH;
    const int ch = c0 + cc * 8;
    float z[8], g1[8];
#pragma unroll
    for (int e = 0; e < 8; e++) { z[e] = cb[1024 + ch + e]; g1[e] = cb[ch + e]; }
#pragma unroll
    for (int dtp = 0; dtp < 3; dtp++) {
      const int tt = t + dtp - 1;
      if (tt >= 0 && tt < L) {
        const u16* pr = P + (size_t)(rowbase + tt) * 6656;
        bf16x8 xv = *(const bf16x8*)(pr + 9 * 512 + ch);
        bf16x8 hv = *(const bf16x8*)(pr + 11 * 512 + ch);
#pragma unroll
        for (int e = 0; e < 8; e++) {
          g1[e] += bf2f(xv[e]) * cw[dtp * 1536 + ch + e];
          z[e] += bf2f(hv[e]) * cw[dtp * 1536 + 1024 + ch + e];
        }
      }
    }
#pragma unroll
    for (int e = 0; e < 8; e++) {
      zb[(cc * 8 + e) * ZLEN + 256 + t] = f2bf(z[e]);
      g1b[(cc * 8 + e) * L + t] = f2bf(g1[e]);
    }
  }
  __syncthreads();
  u16* fb = fball + wave * FBL;
#pragma unroll 1
  for (int q = 0; q < NQ; q++) {
    const int cl = wave + 4 * (q >> 1);
    const int o = q & 1;
    u16* zc = zb + cl * ZLEN;
    {
#pragma unroll
      for (int k = 0; k < NREG; k++) {
        const int i = lane + 64 * k;
        if (i < XLEN / 8) *(bf16x8*)(fb + 16 + i * 8) = fr[k];
      }
      const float invn = 1.f / wave_sum(nrm_pf);
      const float bias = bias_pf;
      if (q + 1 < NQ) fetch_filter(q + 1);
      f32x4 acc[NG];
#pragma unroll
      for (int ng = 0; ng < NG; ng++) acc[ng] = (f32x4){0.f, 0.f, 0.f, 0.f};
      const int ebase = L - l15 + quad * 8 + 16;
#pragma unroll 2
      for (int u = -256; u <= L - 32; u += 32) {
        const bf16x8 bz = *(const bf16x8*)(zc + 256 + u + l15 * 16 + quad * 8);
#pragma unroll
        for (int ng = 0; ng < NG; ng++) {
          const int e0 = ebase - ng * 256 + u;
          const unsigned* fw = (const unsigned*)fb + (e0 >> 1);
          const unsigned sh = (e0 & 1) * 2;
          unsigned d0 = fw[0], d1 = fw[1], d2 = fw[2], d3 = fw[3], d4 = fw[4];
          union { unsigned u4[4]; bf16x8 v; } af;
          af.u4[0] = __builtin_amdgcn_alignbyte(d1, d0, sh);
          af.u4[1] = __builtin_amdgcn_alignbyte(d2, d1, sh);
          af.u4[2] = __builtin_amdgcn_alignbyte(d3, d2, sh);
          af.u4[3] = __builtin_amdgcn_alignbyte(d4, d3, sh);
          acc[ng] = mfma16(af.v, bz, acc[ng]);
        }
      }
#pragma unroll
      for (int ng = 0; ng < NG; ng++) {
        const int t = ng * 256 + l15 * 16 + quad * 4;
        bf16x4 zv = *(const bf16x4*)(zc + 256 + t);
        bf16x4 ov;
        if (o == 0) {
          bf16x4 gv = *(const bf16x4*)(g1b + cl * L + t);
#pragma unroll
          for (int j = 0; j < 4; j++) ov[j] = (short)f2bf(bf2f(gv[j]) * (acc[ng][j] * invn + bf2f(zv[j]) * bias));
        } else {
#pragma unroll
          for (int j = 0; j < 4; j++) ov[j] = (short)f2bf(acc[ng][j] * invn + bf2f(zv[j]) * bias);
        }
        *(bf16x4*)(zc + 256 + t) = ov;
      }
    }
  }
  __syncthreads();
#pragma unroll 2
  for (int idx = tid; idx < L * NCH; idx += 256) {
    const int t = idx / NCH, cc = idx - t * NCH;
    const int ch = c0 + cc * 8;
    float g2[8];
#pragma unroll
    for (int e = 0; e < 8; e++) g2[e] = cb[512 + ch + e];
#pragma unroll
    for (int dtp = 0; dtp < 3; dtp++) {
      const int tt = t + dtp - 1;
      if (tt >= 0 && tt < L) {
        bf16x8 xv = *(const bf16x8*)(P + (size_t)(rowbase + tt) * 6656 + 10 * 512 + ch);
#pragma unroll
        for (int e = 0; e < 8; e++) g2[e] += bf2f(xv[e]) * cw[dtp * 1536 + 512 + ch + e];
      }
    }
    bf16x8 dg = *(const bf16x8*)(P + (size_t)(rowbase + t) * 6656 + 12 * 512 + ch);
    float f[8];
#pragma unroll
    for (int e = 0; e < 8; e++) f[e] = bf2f((short)zb[(cc * 8 + e) * ZLEN + 256 + t]) * g2[e] * silu(bf2f(dg[e]));
    *(bf16x8*)(Y + (size_t)(rowbase + t) * 2048 + 1536 + ch) = pack8(f);
  }
  __syncthreads();
}

#ifndef R_HY
#define R_HY 1
#endif
#ifndef R_AT
#define R_AT 1
#endif
#ifndef R_GP
#define R_GP 1
#endif
DEV void phase_mix(const Params& p, int l, int bid, int nb, char* smem) {
  constexpr int N_HL = 256, N_AL = 256, N_HC = 512, N_AC = 256, N_G = 256, N_PL = 256;
  constexpr int TOT0 = N_HL + N_AL + N_HC + N_AC + N_G + N_PL;
  const int TOT = TOT0 + (l == 0 ? 1088 : 0);
  const int team = __builtin_amdgcn_readfirstlane(threadIdx.x >> 8);
  smem += team * LDS_TEAM;
  volatile LAS unsigned* stq = (volatile LAS unsigned*)(dyn_smem + LDS_MAIN);
  unsigned* cnt = (unsigned*)(p.ws + OFF_CNT) + 16 * (1 + l);
  for (;;) {
    __syncthreads();
    if (threadIdx.x == 0) stq[2] = atomicAdd(cnt, 1u);
    __syncthreads();
    const int jp = (int)stq[2];
    if (jp >= TOT / 2) break;
    int i = jp * 2 + team;
    if (i < N_HL) { for (int r = 0; r < R_HY; r++) hyena_item<1024, 8>(p, l, 1, i >> 6, i & 63, smem); continue; }
    i -= N_HL;
    if (i < N_AL) { for (int r = 0; r < R_AT; r++) attn_item(p, l, 1, i >> 6, (i >> 4) & 3, i & 15, smem); continue; }
    i -= N_AL;
    if (i < N_HC) { for (int r = 0; r < R_HY; r++) hyena_item<256, 16>(p, l, 0, i >> 5, i & 31, smem); continue; }
    i -= N_HC;
    if (i < N_AC) { for (int r = 0; r < R_AT; r++) attn_item(p, l, 0, i >> 4, (i >> 2) & 3, i & 3, smem); continue; }
    i -= N_AC;
    if (i < N_G) { for (int r = 0; r < R_GP; r++) gmlp_item(p, l, i >> 2, i & 3, smem); continue; }
    i -= N_G;
    if (i < N_PL) { for (int r = 0; r < R_GP; r++) pool_item(p, l, i >> 2, i & 3, smem); continue; }
    i -= N_PL;
    if (i < 832) {
      p0_transpose(p.w_in + (size_t)2048 * 6656, (u16*)(p.ws + OFF_WINT) + (size_t)6656 * 2048, 2048, 6656, i / 26, i % 26, smem);
    } else {
      i -= 832;
      p0_transpose(p.w_out + (size_t)2048 * 2048, (u16*)(p.ws + OFF_WOUTT) + (size_t)2048 * 2048, 2048, 2048, i / 8, i % 8, smem);
    }
  }
}


#ifndef REP_PREP
#define REP_PREP 1
#endif
#ifndef REP_ROWS
#define REP_ROWS 1
#endif
#ifndef REP_G1
#define REP_G1 1
#endif
#ifndef REP_MIX
#define REP_MIX 1
#endif
#ifndef REP_G2
#define REP_G2 1
#endif
__global__ void __launch_bounds__(512, 2) mega_kernel(Params p) {
  cg::grid_group grid = cg::this_grid();
  const int bid = blockIdx.x, nb = gridDim.x;
  volatile LAS unsigned* st = (volatile LAS unsigned*)(dyn_smem + LDS_MAIN);
  if (threadIdx.x < 4) st[threadIdx.x] = 0u;
  __syncthreads();
  XcdBarrier xb = xcd_barrier_post((unsigned*)(p.ws + OFF_BAR), st);
  if (p.out == nullptr) grid.sync();
#pragma unroll 1
  for (int r = 0; r < REP_PREP; r++) {
    phase_prep(p, bid, nb, dyn_smem);
    xcd_barrier(xb);
  }
#pragma unroll 1
  for (int l = 0; l < 2; l++) {
#pragma unroll 1
    for (int r = 0; r < REP_ROWS; r++) {
      phase_rows(p, l, l, bid, nb, dyn_smem);
      xcd_barrier(xb);
    }
#pragma unroll 1
    for (int r = 0; r < REP_G1; r++) {
      phase_gemm<1>(p, l, bid, nb, dyn_smem);
      xcd_barrier(xb);
    }
#pragma unroll 1
    for (int r = 0; r < REP_MIX; r++) {
      phase_mix(p, l, bid, nb, dyn_smem);
      xcd_barrier(xb);
    }
#pragma unroll 1
    for (int r = 0; r < REP_G2; r++) {
      phase_gemm<2>(p, l, bid, nb, dyn_smem);
      xcd_barrier(xb);
    }
  }
  phase_rows(p, 2, 1, bid, nb, dyn_smem);
}

extern "C" void kernel_launch(void* const* d_in, const int* in_sizes, int n_in, void* d_out, int out_size, void* d_ws,
                              size_t ws_size, hipStream_t stream) {
  static int grid_blocks = 0;
  if (!grid_blocks) {
    int dev = 0, cus = 0, per_cu = 0;
    (void)hipGetDevice(&dev);
    (void)hipDeviceGetAttribute(&cus, hipDeviceAttributeMultiprocessorCount, dev);
    (void)hipFuncSetAttribute((const void*)mega_kernel, hipFuncAttributeMaxDynamicSharedMemorySize, LDS_BYTES);
    (void)hipOccupancyMaxActiveBlocksPerMultiprocessor(&per_cu, mega_kernel, 512, LDS_BYTES);
    if (per_cu < 1) per_cu = 1;
    if (per_cu > 1) per_cu = 1;
    grid_blocks = cus * per_cu;
  }
  Params p{};
  const float** pp = (const float**)&p;
  for (int i = 0; i < 28; i++) pp[i] = (const float*)d_in[i];
  p.out = (float*)d_out;
  p.ws = (char*)d_ws;
  (void)hipMemsetAsync((char*)d_ws + OFF_BAR, 0, 16384, stream);
  void* args[] = {&p};
  hipError_t e = hipLaunchCooperativeKernel((const void*)mega_kernel, dim3(grid_blocks), dim3(512), args, LDS_BYTES, stream);
  if (e != hipSuccess) fprintf(stderr, "cooperative launch failed: %s (grid %d)\n", hipGetErrorString(e), grid_blocks);
}
```

```cpp
#include <hip/hip_runtime.h>
#include <hip/hip_cooperative_groups.h>
#include <cstdio>
namespace cg = cooperative_groups;

#ifndef COOP
#define COOP 1
#endif

typedef unsigned short u16;
typedef __attribute__((ext_vector_type(8))) short bf16x8;
typedef __attribute__((ext_vector_type(4))) short bf16x4;
typedef __attribute__((ext_vector_type(4))) float f32x4;

#define DEV __device__ __forceinline__

struct Params {
  const float *x_prompt, *x_sample, *cache_k, *cache_v, *c, *c_ctx, *w_mod, *b_mod, *w_in, *gmlp_w, *gmlp_b,
      *pool_w, *pool_scale, *lambda_qk, *subln_w, *conv_w, *conv_b, *filt_w1, *filt_b1, *filt_w2, *filt_b2,
      *filt_freq, *filt_w3, *hyena_bias, *w_out, *b_out, *ln_g, *ln_b;
  float* out;
  char* ws;
};

constexpr int LDS_TEAM = 73728;
constexpr int LDS_MAIN = 2 * LDS_TEAM;
constexpr int LDS_BYTES = LDS_MAIN + 16;
constexpr size_t OFF_WINT = 0;
constexpr size_t OFF_WOUTT = OFF_WINT + 54525952;
constexpr size_t OFF_H = OFF_WOUTT + 16777216;
constexpr size_t OFF_P = OFF_H + 33554432;
constexpr size_t OFF_Y = OFF_P + 109051904;
constexpr size_t OFF_MOD = OFF_Y + 33554432;
constexpr size_t OFF_F0 = OFF_MOD + 245760;
constexpr size_t OFF_F1 = OFF_F0 + 2162688;
constexpr size_t OFF_FN = OFF_F1 + 8454144;
constexpr size_t OFF_ROPE = OFF_FN + 1048576;
constexpr size_t OFF_BAR = OFF_ROPE + 262144;
constexpr size_t OFF_CNT = OFF_BAR + 13824;
constexpr size_t OFF_KC = OFF_BAR + 16384;
constexpr size_t OFF_VC = OFF_KC + 4194304;
constexpr size_t OUT_YS = 8388608;
constexpr size_t OUT_K = 16777216;
constexpr size_t OUT_V = 16777216 + 4194304;

DEV u16 f2bf(float f) {
  unsigned u = __float_as_uint(f);
  u += 0x7fffu + ((u >> 16) & 1u);
  return (u16)(u >> 16);
}
DEV float bf2f(short h) { return __uint_as_float(((unsigned)(u16)h) << 16); }
DEV float silu(float x) { return x / (1.f + __expf(-x)); }
DEV bf16x8 pack8(const float* f) {
  bf16x8 o;
#pragma unroll
  for (int j = 0; j < 8; j++) o[j] = (short)f2bf(f[j]);
  return o;
}
DEV f32x4 mfma16(bf16x8 a, bf16x8 b, f32x4 c) { return __builtin_amdgcn_mfma_f32_16x16x32_bf16(a, b, c, 0, 0, 0); }
DEV bf16x8 tr_read2(unsigned a0, unsigned a1) {
  bf16x4 lo, hi;
  asm volatile("ds_read_b64_tr_b16 %0, %2\n\tds_read_b64_tr_b16 %1, %3\n\ts_waitcnt lgkmcnt(0)"
               : "=&v"(lo), "=&v"(hi)
               : "v"(a0), "v"(a1)
               : "memory");
  bf16x8 r;
  r[0] = lo[0]; r[1] = lo[1]; r[2] = lo[2]; r[3] = lo[3];
  r[4] = hi[0]; r[5] = hi[1]; r[6] = hi[2]; r[7] = hi[3];
  return r;
}
DEV int launder_tid() {
  int t = threadIdx.x & 255;
  asm volatile("" : "+v"(t));
  return t;
}
DEV float wave_sum(float v) {
#pragma unroll
  for (int o = 32; o; o >>= 1) v += __shfl_xor(v, o);
  return v;
}
DEV float block_sum(float v, float* red) {
  v = wave_sum(v);
  __syncthreads();
  if ((threadIdx.x & 63) == 0) red[threadIdx.x >> 6] = v;
  __syncthreads();
  return red[0] + red[1] + red[2] + red[3];
}


#define XB_TMO 128
#define XB_XCNT(j) (256 + 64 * (j))
#define XB_XSUB(j) (1280 + 64 * (j))
#define XB_XGEN(j) (2304 + 64 * (j))
#define XB_TOP 3328
#define XB_TOPGEN 3392
#define XCD_BAR_WORDS 3456
#define XB_SPIN_CAP (1u << 22)
#define LAS __attribute__((address_space(3)))
DEV unsigned xb_ld(unsigned* p) { return __hip_atomic_load(p, __ATOMIC_RELAXED, __HIP_MEMORY_SCOPE_AGENT); }
DEV unsigned xb_add(unsigned* p, unsigned v) { return __hip_atomic_fetch_add(p, v, __ATOMIC_RELAXED, __HIP_MEMORY_SCOPE_AGENT); }
DEV unsigned xb_xcc_id() { return (unsigned)__builtin_amdgcn_s_getreg((3 << 11) | 20) & 0xFu; }
#define XB_SPIN(cond, bar) do { unsigned _sp = 0; while (cond) { __builtin_amdgcn_s_sleep(1); \
    if ((++_sp & 255u) == 0u) { if (xb_ld(&(bar)[XB_TMO])) break; if (_sp > XB_SPIN_CAP) { atomicAdd(&(bar)[XB_TMO], 1u); break; } } } } while (0)
struct XcdBarrier { unsigned* bar; unsigned x; volatile LAS unsigned* st; };
DEV XcdBarrier xcd_barrier_post(unsigned* bar, volatile LAS unsigned* st) {
  XcdBarrier b; b.bar = bar; b.x = xb_xcc_id(); b.st = st;
  if (threadIdx.x == 0) (void)xb_add(&bar[XB_XCNT(b.x)], 1u);
  return b;
}
DEV void xcd_barrier_complete(unsigned* bar, unsigned x, unsigned& nloc, unsigned& nx) {
  const unsigned G = gridDim.x * gridDim.y * gridDim.z;
  unsigned sum, cnt, mine, sp = 0u;
  for (;;) {
    sum = 0u; cnt = 0u; mine = 0u;
#pragma unroll
    for (unsigned j = 0; j < 16; ++j) { const unsigned c = xb_ld(&bar[XB_XCNT(j)]); sum += c; cnt += (c > 0u) ? 1u : 0u; mine = (j == x) ? c : mine; }
    if (sum == G) break;
    __builtin_amdgcn_s_sleep(1);
    if ((++sp & 255u) == 0u) { if (xb_ld(&bar[XB_TMO])) break; if (sp > XB_SPIN_CAP) { atomicAdd(&bar[XB_TMO], 1u); break; } }
  }
  nloc = mine > 0u ? mine : 1u; nx = cnt > 0u ? cnt : 1u;
}
DEV void xcd_barrier(const XcdBarrier& b) {
  asm volatile("s_waitcnt vmcnt(0)" ::: "memory");
  __syncthreads();
  if (threadIdx.x == 0) {
    unsigned* bar = b.bar;
    __builtin_amdgcn_s_waitcnt(0);
    unsigned nloc = b.st[0], nx = b.st[1];
    if (nloc == 0u) { xcd_barrier_complete(bar, b.x, nloc, nx); b.st[0] = nloc; b.st[1] = nx; }
    const unsigned old = xb_add(&bar[XB_XSUB(b.x)], 1u);
    const unsigned gen = old / nloc;
    if (old + 1u == (gen + 1u) * nloc) {
      __builtin_amdgcn_fence(__ATOMIC_RELEASE, "agent");
      asm volatile("s_waitcnt vmcnt(0)" ::: "memory");
      const unsigned og = xb_add(&bar[XB_TOP], 1u);
      const unsigned tg = og / nx;
      if (og + 1u == (tg + 1u) * nx) xb_add(&bar[XB_TOPGEN], 1u);
      else XB_SPIN(xb_ld(&bar[XB_TOPGEN]) == tg, bar);
      __builtin_amdgcn_fence(__ATOMIC_ACQUIRE, "agent");
      xb_add(&bar[XB_XGEN(b.x)], 1u);
      asm volatile("s_waitcnt vmcnt(0)" ::: "memory");
    } else {
      XB_SPIN(xb_ld(&bar[XB_XGEN(b.x)]) == gen, bar);
      __builtin_amdgcn_fence(__ATOMIC_ACQUIRE, "agent");
      asm volatile("s_waitcnt vmcnt(0)" ::: "memory");
    }
  }
  __syncthreads();
}

extern __shared__ __attribute__((aligned(16))) char dyn_smem[];

DEV void p0_transpose(const float* __restrict__ W, u16* __restrict__ WT, int K, int N, int kt, int nt, char* smem) {
  float* sm = (float*)smem;
  const int tid = launder_tid();
  const int k0 = kt * 64, n0 = nt * 256;
  float4 v[16];
#pragma unroll
  for (int i = 0; i < 16; i++) {
    int r = (tid >> 6) + i * 4, c4 = tid & 63;
    v[i] = *(const float4*)(W + (size_t)(k0 + r) * N + n0 + c4 * 4);
  }
#pragma unroll
  for (int i = 0; i < 16; i++) {
    int r = (tid >> 6) + i * 4, c4 = tid & 63;
    float* d = sm + r * 257 + c4 * 4;
    d[0] = v[i].x; d[1] = v[i].y; d[2] = v[i].z; d[3] = v[i].w;
  }
  __syncthreads();
#pragma unroll
  for (int i = 0; i < 8; i++) {
    int ch = tid + i * 256, kc = ch & 7, n = ch >> 3;
    float f[8];
#pragma unroll
    for (int j = 0; j < 8; j++) f[j] = sm[(kc * 8 + j) * 257 + n];
    *(bf16x8*)(WT + (size_t)(n0 + n) * K + k0 + kc * 8) = pack8(f);
  }
  __syncthreads();
}

DEV void p0_mod(const Params& p, int l, int cgp, char* smem) {
  float* s = (float*)smem;
  float* red = s + 10240;
  const int tid = launder_tid();
  for (int i = tid; i < 10240; i += 256) {
    int r = i >> 11, k = i & 2047;
    float cv = (r == 0) ? p.c_ctx[k] : p.c[(r - 1) * 2048 + k];
    s[i] = cv / (1.f + expf(-cv));
  }
  __syncthreads();
  const int cq = tid & 15, ks = tid >> 4;
  const float* W = p.w_mod + (size_t)l * 2048 * 6144 + cgp * 64 + cq * 4;
  float acc[5][4];
#pragma unroll
  for (int r = 0; r < 5; r++)
#pragma unroll
    for (int e = 0; e < 4; e++) acc[r][e] = 0.f;
#pragma unroll 8
  for (int k = ks * 128; k < ks * 128 + 128; k++) {
    float4 w = *(const float4*)(W + (size_t)k * 6144);
#pragma unroll
    for (int r = 0; r < 5; r++) {
      float sv = s[r * 2048 + k];
      acc[r][0] += sv * w.x; acc[r][1] += sv * w.y; acc[r][2] += sv * w.z; acc[r][3] += sv * w.w;
    }
  }
#pragma unroll
  for (int r = 0; r < 5; r++)
#pragma unroll
    for (int e = 0; e < 4; e++) red[(ks * 5 + r) * 64 + cq * 4 + e] = acc[r][e];
  __syncthreads();
  float* MOD = (float*)(p.ws + OFF_MOD);
  for (int i = tid; i < 320; i += 256) {
    int r = i >> 6, col = i & 63;
    float sum = 0.f;
#pragma unroll
    for (int k2 = 0; k2 < 16; k2++) sum += red[(k2 * 5 + r) * 64 + col];
    sum += p.b_mod[l * 6144 + cgp * 64 + col];
    MOD[(l * 5 + r) * 6144 + cgp * 64 + col] = sum;
  }
  __syncthreads();
}

DEV void p0_filter(const Params& p, int l, int path, int chunk, int q, char* smem) {
  const int L = path ? 1024 : 256;
  const int XLEN = 2 * L + 16;
  float* w1s = (float*)smem;
  float* w2s = w1s + 2112;
  float* feats = w2s + 4096;
  float* h1 = feats + 1056;
  float* h2 = h1 + 2048;
  u16* tile = (u16*)smem;
  const int tid = launder_tid();
  const int o = q >> 1, dir = q & 1;
  const float* b1 = p.filt_b1 + l * 64;
  const float* b2 = p.filt_b2 + l * 64;
  const float* fr = p.filt_freq + l * 64;
  const float invLm1 = 1.f / (float)(L - 1);
  __syncthreads();
  for (int i = tid; i < 2112; i += 256) w1s[i] = p.filt_w1[l * 2112 + i];
  for (int i = tid; i < 4096; i += 256) w2s[i] = p.filt_w2[l * 4096 + i];
  for (int e = tid; e < 1056; e += 256) {
    int t = e / 33, f = e - t * 33;
    int tg = chunk * 32 + t;
    float v;
    if (f == 0) v = (float)tg * invLm1;
    else {
      int bb = (f - 1) & 15;
      float band = 1e-4f + (float)bb * ((15.f - 1e-4f) / 15.f);
      float ang = (6.283185307179586f * (float)tg / (float)L) * band;
      v = (f <= 16) ? cosf(ang) : sinf(ang);
    }
    feats[e] = v;
  }
  __syncthreads();
  {
    int t = tid >> 3, j0 = (tid & 7) * 8;
    float a[8];
#pragma unroll
    for (int k = 0; k < 8; k++) a[k] = b1[j0 + k];
#pragma unroll 3
    for (int f = 0; f < 33; f++) {
      float fv = feats[t * 33 + f];
#pragma unroll
      for (int k = 0; k < 8; k++) a[k] += fv * w1s[f * 64 + j0 + k];
    }
#pragma unroll
    for (int k = 0; k < 8; k++) h1[t * 64 + j0 + k] = sinf(fr[j0 + k] * a[k]);
  }
  __syncthreads();
  {
    int t = tid >> 3, j0 = (tid & 7) * 8;
    float a[8];
#pragma unroll
    for (int k = 0; k < 8; k++) a[k] = b2[j0 + k];
#pragma unroll 4
    for (int f = 0; f < 64; f++) {
      float fv = h1[t * 64 + f];
#pragma unroll
      for (int k = 0; k < 8; k++) a[k] += fv * w2s[f * 64 + j0 + k];
    }
#pragma unroll
    for (int k = 0; k < 8; k++) h2[t * 64 + j0 + k] = sinf(fr[j0 + k] * a[k]);
  }
  __syncthreads();
  const float da = logf(1e-2f) / 0.3f, db = logf(1e-2f) / 1.5f;
  float* FNP = (float*)(p.ws + OFF_FN);
#pragma unroll 1
  for (int cc = 0; cc < 2; cc++) {
    const int ch = tid + cc * 256;
    const float* w3 = p.filt_w3 + (size_t)l * 64 * 2048 + q * 512 + ch;
    float w3r[64];
#pragma unroll
    for (int j = 0; j < 64; j++) w3r[j] = w3[j * 2048];
    const float delta = fabsf(da + (db - da) * ((float)ch / 511.f));
    float asum = 0.f;
#pragma unroll 2
    for (int t = 0; t < 32; t++) {
      const int tg = chunk * 32 + t;
      float acc = 0.f;
      const float* hp = h2 + t * 64;
      asm volatile("" : "+v"(hp));
#pragma unroll
      for (int j4 = 0; j4 < 16; j4++) {
        float4 hv = *(const float4*)(hp + j4 * 4);
        acc += hv.x * w3r[j4 * 4] + hv.y * w3r[j4 * 4 + 1] + hv.z * w3r[j4 * 4 + 2] + hv.w * w3r[j4 * 4 + 3];
      }
      float v = acc * expf(-(float)tg * invLm1 * delta);
      if (dir == 0 || tg >= 1) asum += fabsf(v);
      tile[ch * 34 + t] = f2bf(v);
    }
    FNP[((((path * 2 + l) * 4 + q) * 32) + chunk) * 512 + ch] = asum;
  }
  __syncthreads();
  u16* Fb = (u16*)(p.ws + (path ? OFF_F1 : OFF_F0));
  {
    const int hw = tid >> 5, t = tid & 31;
    const int tg = chunk * 32 + t;
    const int x = dir ? L + tg : L - tg;
    const bool ok = (dir == 0) || (tg >= 1);
    for (int ch = hw; ch < 512; ch += 8) {
      if (ok) Fb[((size_t)((l * 2 + o) * 512 + ch)) * XLEN + x] = tile[ch * 34 + t];
    }
  }
  if (chunk == 0) {
    if (dir == 0) {
      for (int ch = tid; ch < 512; ch += 256) Fb[((size_t)((l * 2 + o) * 512 + ch)) * XLEN] = 0;
    } else {
      for (int e = tid; e < 512 * 16; e += 256) Fb[((size_t)((l * 2 + o) * 512 + (e >> 4))) * XLEN + 2 * L + (e & 15)] = 0;
    }
  }
  __syncthreads();
}

DEV void p0_rope(const Params& p, int item) {
  int idx = item * 256 + (threadIdx.x & 255);
  int t = idx >> 5, f = idx & 31;
  int fi = f & 15;
  float inv = powf(10000.f, -(float)(2 * fi) / 32.f);
  float pos = (f < 16) ? (float)(t >> 6) : (float)(t & 63);
  float ang = pos * inv;
  float2 cs;
  cs.x = cosf(ang);
  cs.y = sinf(ang);
  ((float2*)(p.ws + OFF_ROPE))[idx] = cs;
}

DEV void phase_prep(const Params& p, int bid, int nb, char* smem) {
  constexpr int N_MOD = 192, N_FILT = 320, N_TIN = 832, N_TOUT = 256, N_ROPE = 128, N_CVT = 512;
  constexpr int TOT = N_MOD + N_FILT + N_TIN + N_TOUT + N_ROPE + N_CVT;
  const int team = __builtin_amdgcn_readfirstlane(threadIdx.x >> 8);
  smem += team * LDS_TEAM;
  volatile LAS unsigned* stq = (volatile LAS unsigned*)(dyn_smem + LDS_MAIN);
  unsigned* cnt = (unsigned*)(p.ws + OFF_CNT);
  for (;;) {
    __syncthreads();
    if (threadIdx.x == 0) stq[2] = atomicAdd(cnt, 1u);
    __syncthreads();
    const int jp = (int)stq[2];
    if (jp >= TOT / 2) break;
    int i = jp * 2 + team;
    if (i < N_MOD) { p0_mod(p, i / 96, i % 96, smem); continue; }
    i -= N_MOD;
    if (i < N_FILT) {
      if (i < 256) p0_filter(p, i >> 7, 1, (i >> 2) & 31, i & 3, smem);
      else { int k = i - 256; p0_filter(p, k >> 5, 0, (k >> 2) & 7, k & 3, smem); }
      continue;
    }
    i -= N_FILT;
    if (i < N_TIN) {
      int nt = i % 26, kt = i / 26;
      p0_transpose(p.w_in, (u16*)(p.ws + OFF_WINT), 2048, 6656, kt, nt, smem);
      continue;
    }
    i -= N_TIN;
    if (i < N_TOUT) {
      int nt = i % 8, kt = i / 8;
      p0_transpose(p.w_out, (u16*)(p.ws + OFF_WOUTT), 2048, 2048, kt, nt, smem);
      continue;
    }
    i -= N_TOUT;
    if (i < N_ROPE) { p0_rope(p, i); continue; }
    i -= N_ROPE;
    {
      const float* src = (i < 256) ? p.cache_k : p.cache_v;
      u16* dst = (u16*)(p.ws + ((i < 256) ? OFF_KC : OFF_VC));
      const int tl = threadIdx.x & 255;
      const size_t base = (size_t)(i & 255) * 8192;
#pragma unroll
      for (int e = 0; e < 4; e++) {
        const size_t o = base + (size_t)(e * 256 + tl) * 8;
        float4 a = *(const float4*)(src + o), c2 = *(const float4*)(src + o + 4);
        float f[8] = {a.x, a.y, a.z, a.w, c2.x, c2.y, c2.z, c2.w};
        *(bf16x8*)(dst + o) = pack8(f);
      }
    }
  }
}

DEV void phase_rows(const Params& p, int mode, int l, int bid, int nb, char* smem) {
  const int lane = threadIdx.x & 63, wave = threadIdx.x >> 6;
  const float* MOD = (const float*)(p.ws + OFF_MOD);
  const float* PRE = (const float*)(p.ws + OFF_P);
  u16* H = (u16*)(p.ws + OFF_H);
  for (int row = bid * 8 + wave; row < 8192; row += nb * 8) {
    const float* src;
    if (mode == 0) src = (row < 4096) ? p.x_prompt + (size_t)row * 2048 : p.x_sample + (size_t)(row - 4096) * 2048;
    else src = PRE + (size_t)row * 2048;
    float4 v[8];
#pragma unroll
    for (int k = 0; k < 8; k++) v[k] = *(const float4*)(src + k * 256 + lane * 4);
    if (mode != 0) {
      const int lp = (mode == 1) ? l - 1 : 1;
      float s = 0.f;
#pragma unroll
      for (int k = 0; k < 8; k++) s += v[k].x + v[k].y + v[k].z + v[k].w;
      const float mean = wave_sum(s) * (1.f / 2048.f);
      float q = 0.f;
#pragma unroll
      for (int k = 0; k < 8; k++) {
        v[k].x -= mean; v[k].y -= mean; v[k].z -= mean; v[k].w -= mean;
        q += v[k].x * v[k].x + v[k].y * v[k].y + v[k].z * v[k].z + v[k].w * v[k].w;
      }
      const float rstd = rsqrtf(wave_sum(q) * (1.f / 2048.f) + 1e-6f);
      const float* g = p.ln_g + lp * 2048;
      const float* bb = p.ln_b + lp * 2048;
#pragma unroll
      for (int k = 0; k < 8; k++) {
        const int c0 = k * 256 + lane * 4;
        float4 g4 = *(const float4*)(g + c0), b4 = *(const float4*)(bb + c0);
        v[k].x = v[k].x * rstd * g4.x + b4.x; v[k].y = v[k].y * rstd * g4.y + b4.y;
        v[k].z = v[k].z * rstd * g4.z + b4.z; v[k].w = v[k].w * rstd * g4.w + b4.w;
        *(float4*)(p.out + (size_t)row * 2048 + c0) = v[k];
      }
      if (mode == 2) continue;
    }
    float s = 0.f;
#pragma unroll
    for (int k = 0; k < 8; k++) s += v[k].x + v[k].y + v[k].z + v[k].w;
    const float mean = wave_sum(s) * (1.f / 2048.f);
    float q = 0.f;
#pragma unroll
    for (int k = 0; k < 8; k++) {
      v[k].x -= mean; v[k].y -= mean; v[k].z -= mean; v[k].w -= mean;
      q += v[k].x * v[k].x + v[k].y * v[k].y + v[k].z * v[k].z + v[k].w * v[k].w;
    }
    const float rstd = rsqrtf(wave_sum(q) * (1.f / 2048.f) + 1e-6f);
    const int r = row < 4096 ? 0 : 1 + ((row - 4096) >> 10);
    const float* md = MOD + (l * 5 + r) * 6144;
#pragma unroll
    for (int k = 0; k < 8; k++) {
      const int c0 = k * 256 + lane * 4;
      float4 sh = *(const float4*)(md + c0), sc = *(const float4*)(md + 2048 + c0);
      bf16x4 o;
      o[0] = (short)f2bf(v[k].x * rstd * (1.f + sc.x) + sh.x);
      o[1] = (short)f2bf(v[k].y * rstd * (1.f + sc.y) + sh.y);
      o[2] = (short)f2bf(v[k].z * rstd * (1.f + sc.z) + sh.z);
      o[3] = (short)f2bf(v[k].w * rstd * (1.f + sc.w) + sh.w);
      *(bf16x4*)(H + (size_t)row * 2048 + c0) = o;
    }
  }
}

#ifndef REP_ML
#define REP_ML 1
#endif
DEV int lds_byte(int r, int c) {
  int st = (r >> 4) * 2 + (c >> 5), rr = r & 15, cc = c & 31, ob = rr * 64 + cc * 2;
  return st * 1024 + (ob ^ (((ob >> 9) & 1) << 5));
}
DEV void stage_rc(int b, int& R, int& C) {
  int st = b >> 10, sb = b & 1023, swz = sb ^ (((sb >> 9) & 1) << 5);
  R = (st >> 1) * 16 + (swz >> 6);
  C = (st & 1) * 32 + ((swz & 63) >> 1);
}
constexpr int STG = 49152;
template <int MODE>
DEV void gemm_tile(const Params& p, int l, int tm, int tn, char* smem) {
  int tid = threadIdx.x;
  asm volatile("" : "+v"(tid));
  const int lane = tid & 63, wave = tid >> 6, l15 = lane & 15, quad = lane >> 4;
  const int wm = wave >> 1, wn = wave & 1;
  constexpr int N = (MODE == 1) ? 6656 : 2048;
  const u16* A = (const u16*)(p.ws + (MODE == 1 ? OFF_H : OFF_Y));
  const u16* B = (const u16*)(p.ws + (MODE == 1 ? OFF_WINT : OFF_WOUTT)) + (size_t)l * N * 2048;
  const int m0 = tm * 256, n0 = tn * 128;
  int R0, C0, R1, C1;
  stage_rc(tid * 16, R0, C0);
  stage_rc(tid * 16 + 8192, R1, C1);
  const u16* gA0 = A + (size_t)(m0 + R0) * 2048 + C0;
  const u16* gA1 = A + (size_t)(m0 + R1) * 2048 + C1;
  const u16* gB0 = B + (size_t)(n0 + R0) * 2048 + C0;
  const u16* gB1 = B + (size_t)(n0 + R1) * 2048 + C1;
  char* lbase = smem + tid * 16;
  auto issue = [&](int kt, int st) {
    char* d = lbase + st * STG;
    const int ko = kt * 64;
    __builtin_amdgcn_global_load_lds((const unsigned*)(gA0 + ko), (__attribute__((address_space(3))) unsigned*)(d), 16, 0, 0);
    __builtin_amdgcn_global_load_lds((const unsigned*)(gA1 + ko), (__attribute__((address_space(3))) unsigned*)(d + 8192), 16, 0, 0);
    __builtin_amdgcn_global_load_lds((const unsigned*)(gA0 + 128 * 2048 + ko), (__attribute__((address_space(3))) unsigned*)(d + 16384), 16, 0, 0);
    __builtin_amdgcn_global_load_lds((const unsigned*)(gA1 + 128 * 2048 + ko), (__attribute__((address_space(3))) unsigned*)(d + 16384 + 8192), 16, 0, 0);
    __builtin_amdgcn_global_load_lds((const unsigned*)(gB0 + ko), (__attribute__((address_space(3))) unsigned*)(d + 32768), 16, 0, 0);
    __builtin_amdgcn_global_load_lds((const unsigned*)(gB1 + ko), (__attribute__((address_space(3))) unsigned*)(d + 32768 + 8192), 16, 0, 0);
  };
  int aoff[2][4], boff[2][4];
#pragma unroll
  for (int ks = 0; ks < 2; ks++)
#pragma unroll
    for (int i = 0; i < 4; i++) {
      aoff[ks][i] = (wm >> 1) * 16384 + lds_byte((wm & 1) * 64 + i * 16 + l15, ks * 32 + quad * 8);
      boff[ks][i] = 32768 + lds_byte(wn * 64 + i * 16 + l15, ks * 32 + quad * 8);
    }
  f32x4 acc[4][4];
#pragma unroll 1
  for (int rep = 0; rep < REP_ML; rep++) {
#pragma unroll
    for (int i = 0; i < 4; i++)
#pragma unroll
      for (int j = 0; j < 4; j++) acc[i][j] = (f32x4){0.f, 0.f, 0.f, 0.f};
    issue(0, 0);
    issue(1, 1);
    int st = 0;
#pragma unroll 1
    for (int kt = 0; kt < 32; kt++) {
      if (kt < 31) asm volatile("s_waitcnt vmcnt(6)" ::: "memory");
      else asm volatile("s_waitcnt vmcnt(0)" ::: "memory");
      __builtin_amdgcn_s_barrier();
      if (kt + 2 < 32) issue(kt + 2, st >= 1 ? st - 1 : 2);
      const char* sb = smem + st * STG;
#pragma unroll
      for (int ks = 0; ks < 2; ks++) {
        bf16x8 af[4], bfr[4];
#pragma unroll
        for (int i = 0; i < 4; i++) {
          af[i] = *(const bf16x8*)(sb + aoff[ks][i]);
          bfr[i] = *(const bf16x8*)(sb + boff[ks][i]);
        }
#pragma unroll
        for (int mt = 0; mt < 4; mt++)
#pragma unroll
          for (int nt = 0; nt < 4; nt++) acc[mt][nt] = mfma16(af[mt], bfr[nt], acc[mt][nt]);
      }
      st = st == 2 ? 0 : st + 1;
    }
    __builtin_amdgcn_s_barrier();
  }
  float* Cw = (float*)(smem + wave * 17408);
  const int rr = lane >> 3, c8 = (lane & 7) * 8;
  if (MODE == 1) {
    u16* P = (u16*)(p.ws + OFF_P);
    const int piece = n0 >> 9;
    const bool latent = m0 >= 4096;
    const float2* ROPE = (const float2*)(p.ws + OFF_ROPE);
#pragma unroll
    for (int mt = 0; mt < 4; mt++)
#pragma unroll
      for (int j = 0; j < 4; j++) {
        const int lr = mt * 16 + quad * 4 + j;
        float v0 = acc[mt][0][j], v1 = acc[mt][1][j], v2 = acc[mt][2][j], v3 = acc[mt][3][j];
        if (latent && (piece == 5 || piece == 6)) {
          const int t = (m0 + wm * 64 + lr - 4096) & 1023;
          float2 cr = ROPE[t * 32 + l15], cc = ROPE[t * 32 + 16 + l15];
          float a0 = v0 * cr.x - v1 * cr.y, a1 = v1 * cr.x + v0 * cr.y;
          float a2 = v2 * cc.x - v3 * cc.y, a3 = v3 * cc.x + v2 * cc.y;
          v0 = a0; v1 = a1; v2 = a2; v3 = a3;
        }
        float* cw = Cw + lr * 68 + l15;
        cw[0] = v0; cw[16] = v1; cw[32] = v2; cw[48] = v3;
      }
    const bool kvout = !latent && (piece == 6 || piece == 7);
#pragma unroll
    for (int ps = 0; ps < 8; ps++) {
      const int lr = ps * 8 + rr;
      const int row = m0 + wm * 64 + lr;
      const int col = n0 + wn * 64 + c8;
      float4 a = *(const float4*)(Cw + lr * 68 + c8), b4 = *(const float4*)(Cw + lr * 68 + c8 + 4);
      float f[8] = {a.x, a.y, a.z, a.w, b4.x, b4.y, b4.z, b4.w};
      *(bf16x8*)(P + (size_t)row * 6656 + col) = pack8(f);
      if (kvout) {
        const int bb = row >> 8, t = row & 255;
        float* o = p.out + (piece == 6 ? OUT_K : OUT_V) + ((size_t)((bb * 2 + l) * 256 + t)) * 512 + (col - piece * 512);
        *(float4*)o = a;
        *(float4*)(o + 4) = b4;
      }
    }
  } else {
    float* PRE = (float*)(p.ws + OFF_P);
    const float* MOD = (const float*)(p.ws + OFF_MOD);
    const float alpha = 1.41421356237f;
#pragma unroll
    for (int mt = 0; mt < 4; mt++)
#pragma unroll
      for (int j = 0; j < 4; j++) {
        float* cw = Cw + (mt * 16 + quad * 4 + j) * 68 + l15;
        cw[0] = acc[mt][0][j]; cw[16] = acc[mt][1][j]; cw[32] = acc[mt][2][j]; cw[48] = acc[mt][3][j];
      }
#pragma unroll
    for (int ps = 0; ps < 8; ps++) {
      const int lr = ps * 8 + rr;
      const int row = m0 + wm * 64 + lr;
      const int col = n0 + wn * 64 + c8;
      const int r = row < 4096 ? 0 : 1 + ((row - 4096) >> 10);
      const float* gate = MOD + (l * 5 + r) * 6144 + 4096 + col;
      const float* xr = ((l == 0) ? ((row < 4096) ? p.x_prompt + (size_t)row * 2048 : p.x_sample + (size_t)(row - 4096) * 2048)
                                  : p.out + (size_t)row * 2048) + col;
      const float* bo = p.b_out + l * 2048 + col;
      float* dst = PRE + (size_t)row * 2048 + col;
#pragma unroll
      for (int hh = 0; hh < 2; hh++) {
        float4 a = *(const float4*)(Cw + lr * 68 + c8 + hh * 4);
        float4 x4 = *(const float4*)(xr + hh * 4), g4 = *(const float4*)(gate + hh * 4), b4 = *(const float4*)(bo + hh * 4);
        float4 o4;
        o4.x = alpha * x4.x + g4.x * (a.x + b4.x);
        o4.y = alpha * x4.y + g4.y * (a.y + b4.y);
        o4.z = alpha * x4.z + g4.z * (a.z + b4.z);
        o4.w = alpha * x4.w + g4.w * (a.w + b4.w);
        *(float4*)(dst + hh * 4) = o4;
      }
    }
  }
  __builtin_amdgcn_s_waitcnt(0xc07f);
  __builtin_amdgcn_s_barrier();
}

template <int MODE>
DEV void phase_gemm(const Params& p, int l, int bid, int nb, char* smem) {
  constexpr int NT = (MODE == 1) ? 52 : 16;
  for (int t = bid; t < 32 * NT; t += nb) gemm_tile<MODE>(p, l, t & 31, t >> 5, smem);
}

DEV void mm128(const char* Al, const char* Bl, f32x4 (&acc)[2][8], int wave, int lane) {
  const int l15 = lane & 15, quad = lane >> 4, q4 = l15 >> 2, p4 = lane & 3;
  const unsigned bbase = (unsigned)(size_t)Bl + (quad * 8 + q4) * 288 + p4 * 8;
#pragma unroll
  for (int ks = 0; ks < 4; ks++) {
    bf16x8 a[2];
#pragma unroll
    for (int mt = 0; mt < 2; mt++) a[mt] = *(const bf16x8*)(Al + (wave * 32 + mt * 16 + l15) * 272 + ks * 64 + quad * 16);
#pragma unroll
    for (int nt = 0; nt < 8; nt++) {
      bf16x8 b = tr_read2(bbase + ks * 32 * 288 + nt * 32, bbase + ks * 32 * 288 + 4 * 288 + nt * 32);
#pragma unroll
      for (int mt = 0; mt < 2; mt++) acc[mt][nt] = mfma16(a[mt], b, acc[mt][nt]);
    }
  }
}

DEV void load_f32_tile_bf16(const float* src, char* dst, int stride_bytes) {
  const int tid = launder_tid();
#pragma unroll
  for (int i = 0; i < 8; i++) {
    int idx = tid + 256 * i, r = idx >> 4, c8 = idx & 15;
    float4 a = *(const float4*)(src + r * 128 + c8 * 8), b = *(const float4*)(src + r * 128 + c8 * 8 + 4);
    float f[8] = {a.x, a.y, a.z, a.w, b.x, b.y, b.z, b.w};
    *(bf16x8*)(dst + r * stride_bytes + c8 * 16) = pack8(f);
  }
}

DEV void gmlp_item(const Params& p, int l, int chunk, int g, char* smem) {
  char* Al = smem;
  char* Bl = smem + 34816;
  const int tid = launder_tid(), lane = tid & 63, wave = tid >> 6, l15 = lane & 15, quad = lane >> 4;
  const u16* P = (const u16*)(p.ws + OFF_P);
  u16* Y = (u16*)(p.ws + OFF_Y);
  const int r0 = chunk * 128;
  load_f32_tile_bf16(p.gmlp_w + (size_t)(l * 4 + g) * 16384, Al, 272);
#pragma unroll 1
  for (int rb = 0; rb < 4; rb++) {
    bf16x8 vv[8];
#pragma unroll
    for (int k = 0; k < 8; k++) vv[k] = *(const bf16x8*)(P + (size_t)(r0 + wave * 32 + rb * 8 + k) * 6656 + 512 + lane * 8);
#pragma unroll
    for (int k = 0; k < 8; k++) {
      const int j = wave * 32 + rb * 8 + k;
      float f[8];
      float sm1 = 0.f;
#pragma unroll
      for (int e = 0; e < 8; e++) { f[e] = bf2f(vv[k][e]); sm1 += f[e]; }
      const float mean = wave_sum(sm1) * (1.f / 512.f);
      float q = 0.f;
#pragma unroll
      for (int e = 0; e < 8; e++) { f[e] -= mean; q += f[e] * f[e]; }
      const float rstd = rsqrtf(wave_sum(q) * (1.f / 512.f) + 1e-6f);
      if (quad == g) {
#pragma unroll
        for (int e = 0; e < 8; e++) f[e] *= rstd;
        *(bf16x8*)(Bl + j * 288 + l15 * 16) = pack8(f);
      }
    }
  }
  __syncthreads();
  f32x4 acc[2][8];
#pragma unroll
  for (int i = 0; i < 2; i++)
#pragma unroll
    for (int j = 0; j < 8; j++) acc[i][j] = (f32x4){0.f, 0.f, 0.f, 0.f};
  mm128(Al, Bl, acc, wave, lane);
  __syncthreads();
  float* Ct = (float*)smem + wave * 32 * 132;
#pragma unroll
  for (int mt = 0; mt < 2; mt++)
#pragma unroll
    for (int nt = 0; nt < 8; nt++)
#pragma unroll
      for (int j = 0; j < 4; j++) Ct[(mt * 16 + quad * 4 + j) * 132 + nt * 16 + l15] = acc[mt][nt][j];
#pragma unroll 2
  for (int k = 0; k < 8; k++) {
    const int id = lane + 64 * k, r = id >> 4, c8 = (id & 15) * 8;
    const int i = wave * 32 + r;
    const float bs = p.gmlp_b[(l * 4 + g) * 128 + i];
    const u16* pr = P + (size_t)(r0 + i) * 6656 + g * 128 + c8;
    bf16x8 uv = *(const bf16x8*)pr;
    bf16x8 gv = *(const bf16x8*)(pr + 1024);
    float4 a0 = *(const float4*)(Ct + r * 132 + c8), a1 = *(const float4*)(Ct + r * 132 + c8 + 4);
    float av[8] = {a0.x, a0.y, a0.z, a0.w, a1.x, a1.y, a1.z, a1.w};
    float f[8];
#pragma unroll
    for (int e = 0; e < 8; e++) f[e] = silu(bf2f(gv[e])) * bf2f(uv[e]) * (av[e] + bs);
    *(bf16x8*)(Y + (size_t)(r0 + i) * 2048 + g * 128 + c8) = pack8(f);
  }
  __syncthreads();
}

DEV void pool_item(const Params& p, int l, int tile, int g, char* smem) {
  char* Sl = smem;
  char* Al = smem + 36864;
  const int tid = launder_tid(), lane = tid & 63, wave = tid >> 6, l15 = lane & 15, quad = lane >> 4;
  const u16* P = (const u16*)(p.ws + OFF_P);
  u16* Y = (u16*)(p.ws + OFF_Y);
  const int r0 = tile * 128;
  int s0, L;
  if (r0 < 4096) { s0 = r0 & ~255; L = 256; } else { s0 = 4096 + ((r0 - 4096) & ~1023); L = 1024; }
  const int w2 = 1 << g;
  for (int idx = tid; idx < 144 * 16; idx += 256) {
    int rr = idx >> 4, c8 = idx & 15;
    int row = r0 - 8 + rr;
    bf16x8 v = (bf16x8){0, 0, 0, 0, 0, 0, 0, 0};
    if (row >= s0 && row < s0 + L) v = *(const bf16x8*)(P + (size_t)row * 6656 + 3 * 512 + g * 128 + c8 * 8);
    *(bf16x8*)(Sl + rr * 256 + c8 * 16) = v;
  }
  __syncthreads();
#pragma unroll 1
  for (int i = 0; i < 8; i++) {
    int idx = tid + 256 * i, t = idx >> 4, c8 = idx & 15;
    int tl = r0 + t - s0;
    int lo = max(tl - w2, 0), hi = min(tl + w2, L);
    float s[8];
#pragma unroll
    for (int e = 0; e < 8; e++) s[e] = 0.f;
    for (int u = lo; u < hi; u++) {
      bf16x8 v = *(const bf16x8*)(Sl + (u - tl + t + 8) * 256 + c8 * 16);
#pragma unroll
      for (int e = 0; e < 8; e++) s[e] += bf2f(v[e]);
    }
    const float inv = 1.f / (float)(hi - lo);
    bf16x8 cv = *(const bf16x8*)(Sl + (t + 8) * 256 + c8 * 16);
#pragma unroll
    for (int e = 0; e < 8; e++) s[e] = s[e] * inv - bf2f(cv[e]);
    *(bf16x8*)(Al + t * 272 + c8 * 16) = pack8(s);
  }
  __syncthreads();
  load_f32_tile_bf16(p.pool_w + (size_t)(l * 4 + g) * 16384, Sl, 288);
  __syncthreads();
  f32x4 acc[2][8];
#pragma unroll
  for (int i = 0; i < 2; i++)
#pragma unroll
    for (int j = 0; j < 8; j++) acc[i][j] = (f32x4){0.f, 0.f, 0.f, 0.f};
  mm128(Al, Sl, acc, wave, lane);
  __syncthreads();
  float* Ct = (float*)smem + wave * 32 * 132;
#pragma unroll
  for (int mt = 0; mt < 2; mt++)
#pragma unroll
    for (int nt = 0; nt < 8; nt++)
#pragma unroll
      for (int j = 0; j < 4; j++) Ct[(mt * 16 + quad * 4 + j) * 132 + nt * 16 + l15] = acc[mt][nt][j];
#pragma unroll 2
  for (int k = 0; k < 8; k++) {
    const int id = lane + 64 * k, r = id >> 4, c8 = (id & 15) * 8;
    const int row = r0 + wave * 32 + r;
    bf16x8 gv = *(const bf16x8*)(P + (size_t)row * 6656 + 4 * 512 + g * 128 + c8);
    const float* psc = p.pool_scale + l * 512 + g * 128 + c8;
    float4 s0 = *(const float4*)psc, s1 = *(const float4*)(psc + 4);
    float sv[8] = {s0.x, s0.y, s0.z, s0.w, s1.x, s1.y, s1.z, s1.w};
    float4 a0 = *(const float4*)(Ct + r * 132 + c8), a1 = *(const float4*)(Ct + r * 132 + c8 + 4);
    float av[8] = {a0.x, a0.y, a0.z, a0.w, a1.x, a1.y, a1.z, a1.w};
    float f[8];
#pragma unroll
    for (int e = 0; e < 8; e++) f[e] = av[e] * sv[e] * silu(bf2f(gv[e]));
    *(bf16x8*)(Y + (size_t)row * 2048 + 512 + g * 128 + c8) = pack8(f);
  }
  __syncthreads();
}

DEV void attn_item(const Params& p, int l, int path, int b, int h, int qb, char* smem) {
  char* Kl = smem;
  char* Vl = smem + 17408;
  float* Ol = (float*)smem;
  const int tid = launder_tid(), lane = tid & 63, wave = tid >> 6, l15 = lane & 15, quad = lane >> 4;
  const int q4 = l15 >> 2, p4 = lane & 3;
  const u16* P = (const u16*)(p.ws + OFF_P);
  u16* Y = (u16*)(p.ws + OFF_Y);
  const int rowbase = path ? 4096 + b * 1024 : b * 256;
  const int nkeys = path ? 1536 : 256;
  const int ncache = path ? 512 : 0;
  const float* lq = p.lambda_qk + l * 256;
  const float d01 = wave_sum(lq[lane] * lq[64 + lane]);
  const float d23 = wave_sum(lq[128 + lane] * lq[192 + lane]);
  const float lam_init = 0.8f - 0.6f * expf(-0.3f * (float)l);
  const float lam = expf(d01) - expf(d23) + lam_init;
  bf16x8 qf[2][2];
  {
    const int qrow = rowbase + qb * 64 + wave * 16 + l15;
#pragma unroll
    for (int m = 0; m < 2; m++)
#pragma unroll
      for (int ks = 0; ks < 2; ks++) {
        bf16x8 v = *(const bf16x8*)(P + (size_t)qrow * 6656 + 5 * 512 + h * 128 + m * 64 + ks * 32 + quad * 8);
#pragma unroll
        for (int e = 0; e < 8; e++) v[e] = (short)f2bf(bf2f(v[e]) * 0.125f);
        qf[m][ks] = v;
      }
  }
  f32x4 o[2][8];
#pragma unroll
  for (int m = 0; m < 2; m++)
#pragma unroll
    for (int dt = 0; dt < 8; dt++) o[m][dt] = (f32x4){0.f, 0.f, 0.f, 0.f};
  float mrun[2] = {-1e30f, -1e30f}, lrun[2] = {0.f, 0.f};
  const unsigned vbase = (unsigned)(size_t)Vl + (quad * 4 + q4) * 288 + p4 * 8;
  const u16* KC = (const u16*)(p.ws + OFF_KC);
  const u16* VC = (const u16*)(p.ws + OFF_VC);
  const int ntile = nkeys >> 6;
  bf16x8 rk[4], rv[4];
  auto gload = [&](int t) {
    const int kt0 = t * 64;
#pragma unroll
    for (int i = 0; i < 4; i++) {
      const int chunk = tid + 256 * i, key = chunk >> 4, dc = chunk & 15;
      const int kg = kt0 + key;
      if (kt0 < ncache) {
        const size_t off = (((size_t)b * 2 + l) * 512 + kg) * 512 + h * 128 + dc * 8;
        rk[i] = *(const bf16x8*)(KC + off);
        rv[i] = *(const bf16x8*)(VC + off);
      } else {
        const size_t row = rowbase + (kg - ncache);
        rk[i] = *(const bf16x8*)(P + row * 6656 + 6 * 512 + h * 128 + dc * 8);
        rv[i] = *(const bf16x8*)(P + row * 6656 + 7 * 512 + h * 128 + dc * 8);
      }
    }
  };
  auto lstore = [&](int st) {
#pragma unroll
    for (int i = 0; i < 4; i++) {
      const int chunk = tid + 256 * i, key = chunk >> 4, dc = chunk & 15;
      *(bf16x8*)(Kl + st * 35840 + key * 272 + dc * 16) = rk[i];
      *(bf16x8*)(Vl + st * 35840 + key * 288 + dc * 16) = rv[i];
    }
  };
  __syncthreads();
  gload(0);
  lstore(0);
  if (ntile > 1) gload(1);
  __syncthreads();
#pragma unroll 1
  for (int t = 0; t < ntile; t++) {
    const int stg = t & 1;
    const char* Kc = Kl + stg * 35840;
    const unsigned vb = vbase + stg * 35840;
    if (t + 1 < ntile) {
      lstore(stg ^ 1);
      if (t + 2 < ntile) gload(t + 2);
    }
    __builtin_amdgcn_sched_barrier(0);
    f32x4 s[2][4];
#pragma unroll
    for (int m = 0; m < 2; m++)
#pragma unroll
      for (int kt = 0; kt < 4; kt++) {
        f32x4 a4 = (f32x4){0.f, 0.f, 0.f, 0.f};
#pragma unroll
        for (int ks = 0; ks < 2; ks++) {
          bf16x8 a = *(const bf16x8*)(Kc + (kt * 16 + l15) * 272 + m * 128 + ks * 64 + quad * 16);
          a4 = mfma16(a, qf[m][ks], a4);
        }
        s[m][kt] = a4;
      }
    bf16x8 pf[2][2];
#pragma unroll
    for (int m = 0; m < 2; m++) {
      float tmax = -1e30f;
#pragma unroll
      for (int kt = 0; kt < 4; kt++)
#pragma unroll
        for (int j = 0; j < 4; j++) tmax = fmaxf(tmax, s[m][kt][j]);
      tmax = fmaxf(tmax, __shfl_xor(tmax, 16));
      tmax = fmaxf(tmax, __shfl_xor(tmax, 32));
      const float mnew = fmaxf(mrun[m], tmax);
      const float alpha = __expf(mrun[m] - mnew);
      mrun[m] = mnew;
      float psum = 0.f;
#pragma unroll
      for (int kt = 0; kt < 4; kt++)
#pragma unroll
        for (int j = 0; j < 4; j++) {
          float pv = __expf(s[m][kt][j] - mnew);
          psum += pv;
          s[m][kt][j] = pv;
        }
      lrun[m] = lrun[m] * alpha + psum;
#pragma unroll
      for (int dt = 0; dt < 8; dt++) {
        o[m][dt][0] *= alpha; o[m][dt][1] *= alpha; o[m][dt][2] *= alpha; o[m][dt][3] *= alpha;
      }
#pragma unroll
      for (int kk = 0; kk < 2; kk++) {
        bf16x8 t;
#pragma unroll
        for (int j = 0; j < 4; j++) {
          t[j] = (short)f2bf(s[m][2 * kk][j]);
          t[4 + j] = (short)f2bf(s[m][2 * kk + 1][j]);
        }
        pf[m][kk] = t;
      }
    }
#pragma unroll
    for (int kk = 0; kk < 2; kk++)
#pragma unroll
      for (int dt = 0; dt < 8; dt++) {
        bf16x8 a = tr_read2(vb + (2 * kk) * 16 * 288 + dt * 32, vb + (2 * kk + 1) * 16 * 288 + dt * 32);
        o[0][dt] = mfma16(a, pf[0][kk], o[0][dt]);
        o[1][dt] = mfma16(a, pf[1][kk], o[1][dt]);
        if (dt & 1) __builtin_amdgcn_sched_barrier(0);
      }
    __syncthreads();
  }
  float l0 = lrun[0], l1 = lrun[1];
  l0 += __shfl_xor(l0, 16); l0 += __shfl_xor(l0, 32);
  l1 += __shfl_xor(l1, 16); l1 += __shfl_xor(l1, 32);
  const float i0 = 1.f / l0, i1 = lam / l1;
  float ss = 0.f;
#pragma unroll
  for (int dt = 0; dt < 8; dt++)
#pragma unroll
    for (int j = 0; j < 4; j++) {
      float v = o[0][dt][j] * i0 - o[1][dt][j] * i1;
      o[0][dt][j] = v;
      ss += v * v;
    }
  ss += __shfl_xor(ss, 16);
  ss += __shfl_xor(ss, 32);
  const float sc = rsqrtf(ss * (1.f / 128.f) + 1e-5f) * (1.f - lam_init);
  __syncthreads();
#pragma unroll
  for (int dt = 0; dt < 8; dt++)
#pragma unroll
    for (int j = 0; j < 4; j++) Ol[(wave * 16 + l15) * 132 + dt * 16 + quad * 4 + j] = o[0][dt][j] * sc;
  __syncthreads();
#pragma unroll
  for (int i = 0; i < 4; i++) {
    const int idx = tid + 256 * i, qr = idx >> 4, dc = idx & 15;
    const size_t row = rowbase + qb * 64 + qr;
    bf16x8 gv = *(const bf16x8*)(P + row * 6656 + 8 * 512 + h * 128 + dc * 8);
    float f[8];
#pragma unroll
    for (int e = 0; e < 8; e++) f[e] = Ol[qr * 132 + dc * 8 + e] * p.subln_w[l * 128 + dc * 8 + e] * silu(bf2f(gv[e]));
    *(bf16x8*)(Y + row * 2048 + 1024 + h * 128 + dc * 8) = pack8(f);
  }
  __syncthreads();
}

template <int L, int CG>
DEV void hyena_item(const Params& p, int l, int path, int b, int cgi, char* smem) {
  constexpr int ZLEN = L + 512;
  constexpr int XLEN = 2 * L + 16;
  constexpr int FBL = 2 * L + 32;
  constexpr int NG = L / 256;
  constexpr int NCH = CG / 8;
  u16* zb = (u16*)smem;
  u16* g1b = zb + CG * ZLEN;
  u16* fball = g1b + CG * L;
  const int tid = launder_tid(), lane = tid & 63, wave = tid >> 6, l15 = lane & 15, quad = lane >> 4;
  const u16* P = (const u16*)(p.ws + OFF_P);
  u16* Y = (u16*)(p.ws + OFF_Y);
  const int rowbase = path ? 4096 + b * 1024 : b * 256;
  const int c0 = cgi * CG;
  const float* cw = p.conv_w + l * 3 * 1536;
  const float* cb = p.conv_b + l * 1536;
  __syncthreads();
  for (int i = tid; i < CG * 512; i += 256) {
    int c = i >> 9, x = i & 511;
    zb[c * ZLEN + (x < 256 ? x : L + x)] = 0;
  }
  if (lane < 16) fball[wave * FBL + lane] = 0;
  constexpr int NREG = (XLEN / 8 + 63) / 64;
  constexpr int NQ = (CG / 4) * 2;
  const u16* Fg = (const u16*)(p.ws + (path ? OFF_F1 : OFF_F0));
  const float* FN = (const float*)(p.ws + OFF_FN);
  bf16x8 fr[NREG];
  float nrm_pf = 0.f, bias_pf = 0.f;
  auto fetch_filter = [&](int q) {
    const int chq = c0 + wave + 4 * (q >> 1), oq = q & 1;
    const u16* R = Fg + ((size_t)((l * 2 + oq) * 512 + chq)) * XLEN;
#pragma unroll
    for (int k = 0; k < NREG; k++) {
      const int i = lane + 64 * k;
      if (i < XLEN / 8) fr[k] = *(const bf16x8*)(R + i * 8);
    }
    nrm_pf = 0.f;
    if (lane < 2 * (L / 32)) nrm_pf = FN[((((path * 2 + l) * 4 + oq * 2 + (lane & 1)) * 32) + (lane >> 1)) * 512 + chq];
    bias_pf = p.hyena_bias[(l * 2 + oq) * 512 + chq];
  };
  fetch_filter(0);
#pragma unroll 2
  for (int idx = tid; idx < L * NCH; idx += 256) {
    const int t = idx / NCH, cc = idx - t * NCH;
    const int ch = c0 + cc * 8;
    float z[8], g1[8];
#pragma unroll
    for (int e = 0; e < 8; e++) { z[e] = cb[1024 + ch + e]; g1[e] = cb[ch + e]; }
#pragma unroll
    for (int dtp = 0; dtp < 3; dtp++) {
      const int tt = t + dtp - 1;
      if (tt >= 0 && tt < L) {
        const u16* pr = P + (size_t)(rowbase + tt) * 6656;
        bf16x8 xv = *(const bf16x8*)(pr + 9 * 512 + ch);
        bf16x8 hv = *(const bf16x8*)(pr + 11 * 512 + ch);
#pragma unroll
        for (int e = 0; e < 8; e++) {
          g1[e] += bf2f(xv[e]) * cw[dtp * 1536 + ch + e];
          z[e] += bf2f(hv[e]) * cw[dtp * 1536 + 1024 + ch + e];
        }
      }
    }
#pragma unroll
    for (int e = 0; e < 8; e++) {
      zb[(cc * 8 + e) * ZLEN + 256 + t] = f2bf(z[e]);
      g1b[(cc * 8 + e) * L + t] = f2bf(g1[e]);
    }
  }
  __syncthreads();
  u16* fb = fball + wave * FBL;
#pragma unroll 1
  for (int q = 0; q < NQ; q++) {
    const int cl = wave + 4 * (q >> 1);
    const int o = q & 1;
    u16* zc = zb + cl * ZLEN;
    {
#pragma unroll
      for (int k = 0; k < NREG; k++) {
        const int i = lane + 64 * k;
        if (i < XLEN / 8) *(bf16x8*)(fb + 16 + i * 8) = fr[k];
      }
      const float invn = 1.f / wave_sum(nrm_pf);
      const float bias = bias_pf;
      if (q + 1 < NQ) fetch_filter(q + 1);
      f32x4 acc[NG];
#pragma unroll
      for (int ng = 0; ng < NG; ng++) acc[ng] = (f32x4){0.f, 0.f, 0.f, 0.f};
      const int ebase = L - l15 + quad * 8 + 16;
#pragma unroll 4
      for (int u = -256; u <= L - 32; u += 32) {
        const bf16x8 bz = *(const bf16x8*)(zc + 256 + u + l15 * 16 + quad * 8);
#pragma unroll
        for (int ng = 0; ng < NG; ng++) {
          const int e0 = ebase - ng * 256 + u;
          const unsigned* fw = (const unsigned*)fb + (e0 >> 1);
          const unsigned sh = (e0 & 1) * 2;
          unsigned d0 = fw[0], d1 = fw[1], d2 = fw[2], d3 = fw[3], d4 = fw[4];
          union { unsigned u4[4]; bf16x8 v; } af;
          af.u4[0] = __builtin_amdgcn_alignbyte(d1, d0, sh);
          af.u4[1] = __builtin_amdgcn_alignbyte(d2, d1, sh);
          af.u4[2] = __builtin_amdgcn_alignbyte(d3, d2, sh);
          af.u4[3] = __builtin_amdgcn_alignbyte(d4, d3, sh);
          acc[ng] = mfma16(af.v, bz, acc[ng]);
        }
      }
#pragma unroll
      for (int ng = 0; ng < NG; ng++) {
        const int t = ng * 256 + l15 * 16 + quad * 4;
        bf16x4 zv = *(const bf16x4*)(zc + 256 + t);
        bf16x4 ov;
        if (o == 0) {
          bf16x4 gv = *(const bf16x4*)(g1b + cl * L + t);
#pragma unroll
          for (int j = 0; j < 4; j++) ov[j] = (short)f2bf(bf2f(gv[j]) * (acc[ng][j] * invn + bf2f(zv[j]) * bias));
        } else {
#pragma unroll
          for (int j = 0; j < 4; j++) ov[j] = (short)f2bf(acc[ng][j] * invn + bf2f(zv[j]) * bias);
        }
        *(bf16x4*)(zc + 256 + t) = ov;
      }
    }
  }
  __syncthreads();
#pragma unroll 2
  for (int idx = tid; idx < L * NCH; idx += 256) {
    const int t = idx / NCH, cc = idx - t * NCH;
    const int ch = c0 + cc * 8;
    float g2[8];
#pragma unroll
    for (int e = 0; e < 8; e++) g2[e] = cb[512 + ch + e];
#pragma unroll
    for (int dtp = 0; dtp < 3; dtp++) {
      const int tt = t + dtp - 1;
      if (tt >= 0 && tt < L) {
        bf16x8 xv = *(const bf16x8*)(P + (size_t)(rowbase + tt) * 6656 + 10 * 512 + ch);
#pragma unroll
        for (int e = 0; e < 8; e++) g2[e] += bf2f(xv[e]) * cw[dtp * 1536 + 512 + ch + e];
      }
    }
    bf16x8 dg = *(const bf16x8*)(P + (size_t)(rowbase + t) * 6656 + 12 * 512 + ch);
    float f[8];
#pragma unroll
    for (int e = 0; e < 8; e++) f[e] = bf2f((short)zb[(cc * 8 + e) * ZLEN + 256 + t]) * g2[e] * silu(bf2f(dg[e]));
    *(bf16x8*)(Y + (size_t)(rowbase + t) * 2048 + 1536 + ch) = pack8(f);
  }
  __syncthreads();
}

#ifndef R_HY
#define R_HY 1
#endif
#ifndef R_AT
#define R_AT 1
#endif
#ifndef R_GP
#define R_GP 1
#endif
DEV void phase_mix(const Params& p, int l, int bid, int nb, char* smem) {
  constexpr int N_HL = 256, N_AL = 256, N_HC = 512, N_AC = 256, N_G = 256, N_PL = 256;
  constexpr int TOT0 = N_HL + N_AL + N_HC + N_AC + N_G + N_PL;
  const int TOT = TOT0 + (l == 0 ? 1088 : 0);
  const int team = __builtin_amdgcn_readfirstlane(threadIdx.x >> 8);
  smem += team * LDS_TEAM;
  volatile LAS unsigned* stq = (volatile LAS unsigned*)(dyn_smem + LDS_MAIN);
  unsigned* cnt = (unsigned*)(p.ws + OFF_CNT) + 16 * (1 + l);
  for (;;) {
    __syncthreads();
    if (threadIdx.x == 0) stq[2] = atomicAdd(cnt, 1u);
    __syncthreads();
    const int jp = (int)stq[2];
    if (jp >= TOT / 2) break;
    int i = jp * 2 + team;
    if (i < N_HL) { for (int r = 0; r < R_HY; r++) hyena_item<1024, 8>(p, l, 1, i >> 6, i & 63, smem); continue; }
    i -= N_HL;
    if (i < N_AL) { for (int r = 0; r < R_AT; r++) attn_item(p, l, 1, i >> 6, (i >> 4) & 3, i & 15, smem); continue; }
    i -= N_AL;
    if (i < N_HC) { for (int r = 0; r < R_HY; r++) hyena_item<256, 16>(p, l, 0, i >> 5, i & 31, smem); continue; }
    i -= N_HC;
    if (i < N_AC) { for (int r = 0; r < R_AT; r++) attn_item(p, l, 0, i >> 4, (i >> 2) & 3, i & 3, smem); continue; }
    i -= N_AC;
    if (i < N_G) { for (int r = 0; r < R_GP; r++) gmlp_item(p, l, i >> 2, i & 3, smem); continue; }
    i -= N_G;
    if (i < N_PL) { for (int r = 0; r < R_GP; r++) pool_item(p, l, i >> 2, i & 3, smem); continue; }
    i -= N_PL;
    if (i < 832) {
      p0_transpose(p.w_in + (size_t)2048 * 6656, (u16*)(p.ws + OFF_WINT) + (size_t)6656 * 2048, 2048, 6656, i / 26, i % 26, smem);
    } else {
      i -= 832;
      p0_transpose(p.w_out + (size_t)2048 * 2048, (u16*)(p.ws + OFF_WOUTT) + (size_t)2048 * 2048, 2048, 2048, i / 8, i % 8, smem);
    }
  }
}


#ifndef REP_PREP
#define REP_PREP 1
#endif
#ifndef REP_ROWS
#define REP_ROWS 1
#endif
#ifndef REP_G1
#define REP_G1 1
#endif
#ifndef REP_MIX
#define REP_MIX 1
#endif
#ifndef REP_G2
#define REP_G2 1
#endif
__global__ void __launch_bounds__(512, 2) mega_kernel(Params p) {
  cg::grid_group grid = cg::this_grid();
  const int bid = blockIdx.x, nb = gridDim.x;
  volatile LAS unsigned* st = (volatile LAS unsigned*)(dyn_smem + LDS_MAIN);
  if (threadIdx.x < 4) st[threadIdx.x] = 0u;
  __syncthreads();
  XcdBarrier xb = xcd_barrier_post((unsigned*)(p.ws + OFF_BAR), st);
  if (p.out == nullptr) grid.sync();
#pragma unroll 1
  for (int r = 0; r < REP_PREP; r++) {
    phase_prep(p, bid, nb, dyn_smem);
    xcd_barrier(xb);
  }
#pragma unroll 1
  for (int l = 0; l < 2; l++) {
#pragma unroll 1
    for (int r = 0; r < REP_ROWS; r++) {
      phase_rows(p, l, l, bid, nb, dyn_smem);
      xcd_barrier(xb);
    }
#pragma unroll 1
    for (int r = 0; r < REP_G1; r++) {
      phase_gemm<1>(p, l, bid, nb, dyn_smem);
      xcd_barrier(xb);
    }
#pragma unroll 1
    for (int r = 0; r < REP_MIX; r++) {
      phase_mix(p, l, bid, nb, dyn_smem);
      xcd_barrier(xb);
    }
#pragma unroll 1
    for (int r = 0; r < REP_G2; r++) {
      phase_gemm<2>(p, l, bid, nb, dyn_smem);
      xcd_barrier(xb);
    }
  }
  phase_rows(p, 2, 1, bid, nb, dyn_smem);
}

extern "C" void kernel_launch(void* const* d_in, const int* in_sizes, int n_in, void* d_out, int out_size, void* d_ws,
                              size_t ws_size, hipStream_t stream) {
  static int grid_blocks = 0;
  if (!grid_blocks) {
    int dev = 0, cus = 0, per_cu = 0;
    (void)hipGetDevice(&dev);
    (void)hipDeviceGetAttribute(&cus, hipDeviceAttributeMultiprocessorCount, dev);
    (void)hipFuncSetAttribute((const void*)mega_kernel, hipFuncAttributeMaxDynamicSharedMemorySize, LDS_BYTES);
    (void)hipOccupancyMaxActiveBlocksPerMultiprocessor(&per_cu, mega_kernel, 512, LDS_BYTES);
    if (per_cu < 1) per_cu = 1;
    if (per_cu > 1) per_cu = 1;
    grid_blocks = cus * per_cu;
  }
  Params p{};
  const float** pp = (const float**)&p;
  for (int i = 0; i < 28; i++) pp[i] = (const float*)d_in[i];
  p.out = (float*)d_out;
  p.ws = (char*)d_ws;
  (void)hipMemsetAsync((char*)d_ws + OFF_BAR, 0, 16384, stream);
  void* args[] = {&p};
  hipError_t e = hipLaunchCooperativeKernel((const void*)mega_kernel, dim3(grid_blocks), dim3(512), args, LDS_BYTES, stream);
  if (e != hipSuccess) fprintf(stderr, "cooperative launch failed: %s (grid %d)\n", hipGetErrorString(e), grid_blocks);
}
```

```cpp
#include <hip/hip_runtime.h>
#include <hip/hip_cooperative_groups.h>
#include <cstdio>
namespace cg = cooperative_groups;

#ifndef COOP
#define COOP 1
#endif

typedef unsigned short u16;
typedef __attribute__((ext_vector_type(8))) short bf16x8;
typedef __attribute__((ext_vector_type(4))) short bf16x4;
typedef __attribute__((ext_vector_type(4))) float f32x4;

#define DEV __device__ __forceinline__

struct Params {
  const float *x_prompt, *x_sample, *cache_k, *cache_v, *c, *c_ctx, *w_mod, *b_mod, *w_in, *gmlp_w, *gmlp_b,
      *pool_w, *pool_scale, *lambda_qk, *subln_w, *conv_w, *conv_b, *filt_w1, *filt_b1, *filt_w2, *filt_b2,
      *filt_freq, *filt_w3, *hyena_bias, *w_out, *b_out, *ln_g, *ln_b;
  float* out;
  char* ws;
};

constexpr int LDS_TEAM = 73728;
constexpr int LDS_MAIN = 2 * LDS_TEAM;
constexpr int LDS_BYTES = LDS_MAIN + 16;
constexpr size_t OFF_WINT = 0;
constexpr size_t OFF_WOUTT = OFF_WINT + 54525952;
constexpr size_t OFF_H = OFF_WOUTT + 16777216;
constexpr size_t OFF_P = OFF_H + 33554432;
constexpr size_t OFF_Y = OFF_P + 109051904;
constexpr size_t OFF_MOD = OFF_Y + 33554432;
constexpr size_t OFF_F0 = OFF_MOD + 245760;
constexpr size_t OFF_F1 = OFF_F0 + 2162688;
constexpr size_t OFF_FN = OFF_F1 + 8454144;
constexpr size_t OFF_ROPE = OFF_FN + 1048576;
constexpr size_t OFF_BAR = OFF_ROPE + 262144;
constexpr size_t OFF_CNT = OFF_BAR + 13824;
constexpr size_t OFF_KC = OFF_BAR + 16384;
constexpr size_t OFF_VC = OFF_KC + 4194304;
constexpr size_t OUT_YS = 8388608;
constexpr size_t OUT_K = 16777216;
constexpr size_t OUT_V = 16777216 + 4194304;

DEV u16 f2bf(float f) {
  unsigned u = __float_as_uint(f);
  u += 0x7fffu + ((u >> 16) & 1u);
  return (u16)(u >> 16);
}
DEV float bf2f(short h) { return __uint_as_float(((unsigned)(u16)h) << 16); }
DEV float silu(float x) { return x / (1.f + __expf(-x)); }
DEV bf16x8 pack8(const float* f) {
  bf16x8 o;
#pragma unroll
  for (int j = 0; j < 8; j++) o[j] = (short)f2bf(f[j]);
  return o;
}
DEV f32x4 mfma16(bf16x8 a, bf16x8 b, f32x4 c) { return __builtin_amdgcn_mfma_f32_16x16x32_bf16(a, b, c, 0, 0, 0); }
DEV bf16x8 tr_read2(unsigned a0, unsigned a1) {
  bf16x4 lo, hi;
  asm volatile("ds_read_b64_tr_b16 %0, %2\n\tds_read_b64_tr_b16 %1, %3\n\ts_waitcnt lgkmcnt(0)"
               : "=&v"(lo), "=&v"(hi)
               : "v"(a0), "v"(a1)
               : "memory");
  bf16x8 r;
  r[0] = lo[0]; r[1] = lo[1]; r[2] = lo[2]; r[3] = lo[3];
  r[4] = hi[0]; r[5] = hi[1]; r[6] = hi[2]; r[7] = hi[3];
  return r;
}
DEV int launder_tid() {
  int t = threadIdx.x & 255;
  asm volatile("" : "+v"(t));
  return t;
}
DEV float wave_sum(float v) {
#pragma unroll
  for (int o = 32; o; o >>= 1) v += __shfl_xor(v, o);
  return v;
}
DEV float block_sum(float v, float* red) {
  v = wave_sum(v);
  __syncthreads();
  if ((threadIdx.x & 63) == 0) red[threadIdx.x >> 6] = v;
  __syncthreads();
  return red[0] + red[1] + red[2] + red[3];
}


#define XB_TMO 128
#define XB_XCNT(j) (256 + 64 * (j))
#define XB_XSUB(j) (1280 + 64 * (j))
#define XB_XGEN(j) (2304 + 64 * (j))
#define XB_TOP 3328
#define XB_TOPGEN 3392
#define XCD_BAR_WORDS 3456
#define XB_SPIN_CAP (1u << 22)
#define LAS __attribute__((address_space(3)))
DEV unsigned xb_ld(unsigned* p) { return __hip_atomic_load(p, __ATOMIC_RELAXED, __HIP_MEMORY_SCOPE_AGENT); }
DEV unsigned xb_add(unsigned* p, unsigned v) { return __hip_atomic_fetch_add(p, v, __ATOMIC_RELAXED, __HIP_MEMORY_SCOPE_AGENT); }
DEV unsigned xb_xcc_id() { return (unsigned)__builtin_amdgcn_s_getreg((3 << 11) | 20) & 0xFu; }
#define XB_SPIN(cond, bar) do { unsigned _sp = 0; while (cond) { __builtin_amdgcn_s_sleep(1); \
    if ((++_sp & 255u) == 0u) { if (xb_ld(&(bar)[XB_TMO])) break; if (_sp > XB_SPIN_CAP) { atomicAdd(&(bar)[XB_TMO], 1u); break; } } } } while (0)
struct XcdBarrier { unsigned* bar; unsigned x; volatile LAS unsigned* st; };
DEV XcdBarrier xcd_barrier_post(unsigned* bar, volatile LAS unsigned* st) {
  XcdBarrier b; b.bar = bar; b.x = xb_xcc_id(); b.st = st;
  if (threadIdx.x == 0) (void)xb_add(&bar[XB_XCNT(b.x)], 1u);
  return b;
}
DEV void xcd_barrier_complete(unsigned* bar, unsigned x, unsigned& nloc, unsigned& nx) {
  const unsigned G = gridDim.x * gridDim.y * gridDim.z;
  unsigned sum, cnt, mine, sp = 0u;
  for (;;) {
    sum = 0u; cnt = 0u; mine = 0u;
#pragma unroll
    for (unsigned j = 0; j < 16; ++j) { const unsigned c = xb_ld(&bar[XB_XCNT(j)]); sum += c; cnt += (c > 0u) ? 1u : 0u; mine = (j == x) ? c : mine; }
    if (sum == G) break;
    __builtin_amdgcn_s_sleep(1);
    if ((++sp & 255u) == 0u) { if (xb_ld(&bar[XB_TMO])) break; if (sp > XB_SPIN_CAP) { atomicAdd(&bar[XB_TMO], 1u); break; } }
  }
  nloc = mine > 0u ? mine : 1u; nx = cnt > 0u ? cnt : 1u;
}
DEV void xcd_barrier(const XcdBarrier& b) {
  asm volatile("s_waitcnt vmcnt(0)" ::: "memory");
  __syncthreads();
  if (threadIdx.x == 0) {
    unsigned* bar = b.bar;
    __builtin_amdgcn_s_waitcnt(0);
    unsigned nloc = b.st[0], nx = b.st[1];
    if (nloc == 0u) { xcd_barrier_complete(bar, b.x, nloc, nx); b.st[0] = nloc; b.st[1] = nx; }
    const unsigned old = xb_add(&bar[XB_XSUB(b.x)], 1u);
    const unsigned gen = old / nloc;
    if (old + 1u == (gen + 1u) * nloc) {
      __builtin_amdgcn_fence(__ATOMIC_RELEASE, "agent");
      asm volatile("s_waitcnt vmcnt(0)" ::: "memory");
      const unsigned og = xb_add(&bar[XB_TOP], 1u);
      const unsigned tg = og / nx;
      if (og + 1u == (tg + 1u) * nx) xb_add(&bar[XB_TOPGEN], 1u);
      else XB_SPIN(xb_ld(&bar[XB_TOPGEN]) == tg, bar);
      __builtin_amdgcn_fence(__ATOMIC_ACQUIRE, "agent");
      xb_add(&bar[XB_XGEN(b.x)], 1u);
      asm volatile("s_waitcnt vmcnt(0)" ::: "memory");
    } else {
      XB_SPIN(xb_ld(&bar[XB_XGEN(b.x)]) == gen, bar);
      __builtin_amdgcn_fence(__ATOMIC_ACQUIRE, "agent");
      asm volatile("s_waitcnt vmcnt(0)" ::: "memory");
    }
  }
  __syncthreads();
}

extern __shared__ __attribute__((aligned(16))) char dyn_smem[];

DEV void p0_transpose(const float* __restrict__ W, u16* __restrict__ WT, int K, int N, int kt, int nt, char* smem) {
  float* sm = (float*)smem;
  const int tid = launder_tid();
  const int k0 = kt * 64, n0 = nt * 256;
  float4 v[16];
#pragma unroll
  for (int i = 0; i < 16; i++) {
    int r = (tid >> 6) + i * 4, c4 = tid & 63;
    v[i] = *(const float4*)(W + (size_t)(k0 + r) * N + n0 + c4 * 4);
  }
#pragma unroll
  for (int i = 0; i < 16; i++) {
    int r = (tid >> 6) + i * 4, c4 = tid & 63;
    float* d = sm + r * 257 + c4 * 4;
    d[0] = v[i].x; d[1] = v[i].y; d[2] = v[i].z; d[3] = v[i].w;
  }
  __syncthreads();
#pragma unroll
  for (int i = 0; i < 8; i++) {
    int ch = tid + i * 256, kc = ch & 7, n = ch >> 3;
    float f[8];
#pragma unroll
    for (int j = 0; j < 8; j++) f[j] = sm[(kc * 8 + j) * 257 + n];
    *(bf16x8*)(WT + (size_t)(n0 + n) * K + k0 + kc * 8) = pack8(f);
  }
  __syncthreads();
}

DEV void p0_mod(const Params& p, int l, int cgp, char* smem) {
  float* s = (float*)smem;
  float* red = s + 10240;
  const int tid = launder_tid();
  for (int i = tid; i < 10240; i += 256) {
    int r = i >> 11, k = i & 2047;
    float cv = (r == 0) ? p.c_ctx[k] : p.c[(r - 1) * 2048 + k];
    s[i] = cv / (1.f + expf(-cv));
  }
  __syncthreads();
  const int cq = tid & 15, ks = tid >> 4;
  const float* W = p.w_mod + (size_t)l * 2048 * 6144 + cgp * 64 + cq * 4;
  float acc[5][4];
#pragma unroll
  for (int r = 0; r < 5; r++)
#pragma unroll
    for (int e = 0; e < 4; e++) acc[r][e] = 0.f;
#pragma unroll 8
  for (int k = ks * 128; k < ks * 128 + 128; k++) {
    float4 w = *(const float4*)(W + (size_t)k * 6144);
#pragma unroll
    for (int r = 0; r < 5; r++) {
      float sv = s[r * 2048 + k];
      acc[r][0] += sv * w.x; acc[r][1] += sv * w.y; acc[r][2] += sv * w.z; acc[r][3] += sv * w.w;
    }
  }
#pragma unroll
  for (int r = 0; r < 5; r++)
#pragma unroll
    for (int e = 0; e < 4; e++) red[(ks * 5 + r) * 64 + cq * 4 + e] = acc[r][e];
  __syncthreads();
  float* MOD = (float*)(p.ws + OFF_MOD);
  for (int i = tid; i < 320; i += 256) {
    int r = i >> 6, col = i & 63;
    float sum = 0.f;
#pragma unroll
    for (int k2 = 0; k2 < 16; k2++) sum += red[(k2 * 5 + r) * 64 + col];
    sum += p.b_mod[l * 6144 + cgp * 64 + col];
    MOD[(l * 5 + r) * 6144 + cgp * 64 + col] = sum;
  }
  __syncthreads();
}

DEV void p0_filter(const Params& p, int l, int path, int chunk, int q, char* smem) {
  const int L = path ? 1024 : 256;
  const int XLEN = 2 * L + 16;
  float* w1s = (float*)smem;
  float* w2s = w1s + 2112;
  float* feats = w2s + 4096;
  float* h1 = feats + 1056;
  float* h2 = h1 + 2048;
  u16* tile = (u16*)smem;
  const int tid = launder_tid();
  const int o = q >> 1, dir = q & 1;
  const float* b1 = p.filt_b1 + l * 64;
  const float* b2 = p.filt_b2 + l * 64;
  const float* fr = p.filt_freq + l * 64;
  const float invLm1 = 1.f / (float)(L - 1);
  __syncthreads();
  for (int i = tid; i < 2112; i += 256) w1s[i] = p.filt_w1[l * 2112 + i];
  for (int i = tid; i < 4096; i += 256) w2s[i] = p.filt_w2[l * 4096 + i];
  for (int e = tid; e < 1056; e += 256) {
    int t = e / 33, f = e - t * 33;
    int tg = chunk * 32 + t;
    float v;
    if (f == 0) v = (float)tg * invLm1;
    else {
      int bb = (f - 1) & 15;
      float band = 1e-4f + (float)bb * ((15.f - 1e-4f) / 15.f);
      float ang = (6.283185307179586f * (float)tg / (float)L) * band;
      v = (f <= 16) ? cosf(ang) : sinf(ang);
    }
    feats[e] = v;
  }
  __syncthreads();
  {
    int t = tid >> 3, j0 = (tid & 7) * 8;
    float a[8];
#pragma unroll
    for (int k = 0; k < 8; k++) a[k] = b1[j0 + k];
#pragma unroll 3
    for (int f = 0; f < 33; f++) {
      float fv = feats[t * 33 + f];
#pragma unroll
      for (int k = 0; k < 8; k++) a[k] += fv * w1s[f * 64 + j0 + k];
    }
#pragma unroll
    for (int k = 0; k < 8; k++) h1[t * 64 + j0 + k] = sinf(fr[j0 + k] * a[k]);
  }
  __syncthreads();
  {
    int t = tid >> 3, j0 = (tid & 7) * 8;
    float a[8];
#pragma unroll
    for (int k = 0; k < 8; k++) a[k] = b2[j0 + k];
#pragma unroll 4
    for (int f = 0; f < 64; f++) {
      float fv = h1[t * 64 + f];
#pragma unroll
      for (int k = 0; k < 8; k++) a[k] += fv * w2s[f * 64 + j0 + k];
    }
#pragma unroll
    for (int k = 0; k < 8; k++) h2[t * 64 + j0 + k] = sinf(fr[j0 + k] * a[k]);
  }
  __syncthreads();
  const float da = logf(1e-2f) / 0.3f, db = logf(1e-2f) / 1.5f;
  float* FNP = (float*)(p.ws + OFF_FN);
#pragma unroll 1
  for (int cc = 0; cc < 2; cc++) {
    const int ch = tid + cc * 256;
    const float* w3 = p.filt_w3 + (size_t)l * 64 * 2048 + q * 512 + ch;
    float w3r[64];
#pragma unroll
    for (int j = 0; j < 64; j++) w3r[j] = w3[j * 2048];
    const float delta = fabsf(da + (db - da) * ((float)ch / 511.f));
    float asum = 0.f;
#pragma unroll 2
    for (int t = 0; t < 32; t++) {
      const int tg = chunk * 32 + t;
      float acc = 0.f;
      const float* hp = h2 + t * 64;
      asm volatile("" : "+v"(hp));
#pragma unroll
      for (int j4 = 0; j4 < 16; j4++) {
        float4 hv = *(const float4*)(hp + j4 * 4);
        acc += hv.x * w3r[j4 * 4] + hv.y * w3r[j4 * 4 + 1] + hv.z * w3r[j4 * 4 + 2] + hv.w * w3r[j4 * 4 + 3];
      }
      float v = acc * expf(-(float)tg * invLm1 * delta);
      if (dir == 0 || tg >= 1) asum += fabsf(v);
      tile[ch * 34 + t] = f2bf(v);
    }
    FNP[((((path * 2 + l) * 4 + q) * 32) + chunk) * 512 + ch] = asum;
  }
  __syncthreads();
  u16* Fb = (u16*)(p.ws + (path ? OFF_F1 : OFF_F0));
  {
    const int hw = tid >> 5, t = tid & 31;
    const int tg = chunk * 32 + t;
    const int x = dir ? L + tg : L - tg;
    const bool ok = (dir == 0) || (tg >= 1);
    for (int ch = hw; ch < 512; ch += 8) {
      if (ok) Fb[((size_t)((l * 2 + o) * 512 + ch)) * XLEN + x] = tile[ch * 34 + t];
    }
  }
  if (chunk == 0) {
    if (dir == 0) {
      for (int ch = tid; ch < 512; ch += 256) Fb[((size_t)((l * 2 + o) * 512 + ch)) * XLEN] = 0;
    } else {
      for (int e = tid; e < 512 * 16; e += 256) Fb[((size_t)((l * 2 + o) * 512 + (e >> 4))) * XLEN + 2 * L + (e & 15)] = 0;
    }
  }
  __syncthreads();
}

DEV void p0_rope(const Params& p, int item) {
  int idx = item * 256 + (threadIdx.x & 255);
  int t = idx >> 5, f = idx & 31;
  int fi = f & 15;
  float inv = powf(10000.f, -(float)(2 * fi) / 32.f);
  float pos = (f < 16) ? (float)(t >> 6) : (float)(t & 63);
  float ang = pos * inv;
  float2 cs;
  cs.x = cosf(ang);
  cs.y = sinf(ang);
  ((float2*)(p.ws + OFF_ROPE))[idx] = cs;
}

DEV void phase_prep(const Params& p, int bid, int nb, char* smem) {
  constexpr int N_MOD = 192, N_FILT = 320, N_TIN = 832, N_TOUT = 256, N_ROPE = 128, N_CVT = 512;
  constexpr int TOT = N_MOD + N_FILT + N_TIN + N_TOUT + N_ROPE + N_CVT;
  const int team = __builtin_amdgcn_readfirstlane(threadIdx.x >> 8);
  smem += team * LDS_TEAM;
  volatile LAS unsigned* stq = (volatile LAS unsigned*)(dyn_smem + LDS_MAIN);
  unsigned* cnt = (unsigned*)(p.ws + OFF_CNT);
  for (;;) {
    __syncthreads();
    if (threadIdx.x == 0) stq[2] = atomicAdd(cnt, 1u);
    __syncthreads();
    const int jp = (int)stq[2];
    if (jp >= TOT / 2) break;
    int i = jp * 2 + team;
    if (i < N_MOD) { p0_mod(p, i / 96, i % 96, smem); continue; }
    i -= N_MOD;
    if (i < N_FILT) {
      if (i < 256) p0_filter(p, i >> 7, 1, (i >> 2) & 31, i & 3, smem);
      else { int k = i - 256; p0_filter(p, k >> 5, 0, (k >> 2) & 7, k & 3, smem); }
      continue;
    }
    i -= N_FILT;
    if (i < N_TIN) {
      int nt = i % 26, kt = i / 26;
      p0_transpose(p.w_in, (u16*)(p.ws + OFF_WINT), 2048, 6656, kt, nt, smem);
      continue;
    }
    i -= N_TIN;
    if (i < N_TOUT) {
      int nt = i % 8, kt = i / 8;
      p0_transpose(p.w_out, (u16*)(p.ws + OFF_WOUTT), 2048, 2048, kt, nt, smem);
      continue;
    }
    i -= N_TOUT;
    if (i < N_ROPE) { p0_rope(p, i); continue; }
    i -= N_ROPE;
    {
      const float* src = (i < 256) ? p.cache_k : p.cache_v;
      u16* dst = (u16*)(p.ws + ((i < 256) ? OFF_KC : OFF_VC));
      const int tl = threadIdx.x & 255;
      const size_t base = (size_t)(i & 255) * 8192;
#pragma unroll
      for (int e = 0; e < 4; e++) {
        const size_t o = base + (size_t)(e * 256 + tl) * 8;
        float4 a = *(const float4*)(src + o), c2 = *(const float4*)(src + o + 4);
        float f[8] = {a.x, a.y, a.z, a.w, c2.x, c2.y, c2.z, c2.w};
        *(bf16x8*)(dst + o) = pack8(f);
      }
    }
  }
}

DEV void phase_rows(const Params& p, int mode, int l, int bid, int nb, char* smem) {
  const int lane = threadIdx.x & 63, wave = threadIdx.x >> 6;
  const float* MOD = (const float*)(p.ws + OFF_MOD);
  const float* PRE = (const float*)(p.ws + OFF_P);
  u16* H = (u16*)(p.ws + OFF_H);
  for (int row = bid * 8 + wave; row < 8192; row += nb * 8) {
    const float* src;
    if (mode == 0) src = (row < 4096) ? p.x_prompt + (size_t)row * 2048 : p.x_sample + (size_t)(row - 4096) * 2048;
    else src = PRE + (size_t)row * 2048;
    float4 v[8];
#pragma unroll
    for (int k = 0; k < 8; k++) v[k] = *(const float4*)(src + k * 256 + lane * 4);
    if (mode != 0) {
      const int lp = (mode == 1) ? l - 1 : 1;
      float s = 0.f;
#pragma unroll
      for (int k = 0; k < 8; k++) s += v[k].x + v[k].y + v[k].z + v[k].w;
      const float mean = wave_sum(s) * (1.f / 2048.f);
      float q = 0.f;
#pragma unroll
      for (int k = 0; k < 8; k++) {
        v[k].x -= mean; v[k].y -= mean; v[k].z -= mean; v[k].w -= mean;
        q += v[k].x * v[k].x + v[k].y * v[k].y + v[k].z * v[k].z + v[k].w * v[k].w;
      }
      const float rstd = rsqrtf(wave_sum(q) * (1.f / 2048.f) + 1e-6f);
      const float* g = p.ln_g + lp * 2048;
      const float* bb = p.ln_b + lp * 2048;
#pragma unroll
      for (int k = 0; k < 8; k++) {
        const int c0 = k * 256 + lane * 4;
        float4 g4 = *(const float4*)(g + c0), b4 = *(const float4*)(bb + c0);
        v[k].x = v[k].x * rstd * g4.x + b4.x; v[k].y = v[k].y * rstd * g4.y + b4.y;
        v[k].z = v[k].z * rstd * g4.z + b4.z; v[k].w = v[k].w * rstd * g4.w + b4.w;
        *(float4*)(p.out + (size_t)row * 2048 + c0) = v[k];
      }
      if (mode == 2) continue;
    }
    float s = 0.f;
#pragma unroll
    for (int k = 0; k < 8; k++) s += v[k].x + v[k].y + v[k].z + v[k].w;
    const float mean = wave_sum(s) * (1.f / 2048.f);
    float q = 0.f;
#pragma unroll
    for (int k = 0; k < 8; k++) {
      v[k].x -= mean; v[k].y -= mean; v[k].z -= mean; v[k].w -= mean;
      q += v[k].x * v[k].x + v[k].y * v[k].y + v[k].z * v[k].z + v[k].w * v[k].w;
    }
    const float rstd = rsqrtf(wave_sum(q) * (1.f / 2048.f) + 1e-6f);
    const int r = row < 4096 ? 0 : 1 + ((row - 4096) >> 10);
    const float* md = MOD + (l * 5 + r) * 6144;
#pragma unroll
    for (int k = 0; k < 8; k++) {
      const int c0 = k * 256 + lane * 4;
      float4 sh = *(const float4*)(md + c0), sc = *(const float4*)(md + 2048 + c0);
      bf16x4 o;
      o[0] = (short)f2bf(v[k].x * rstd * (1.f + sc.x) + sh.x);
      o[1] = (short)f2bf(v[k].y * rstd * (1.f + sc.y) + sh.y);
      o[2] = (short)f2bf(v[k].z * rstd * (1.f + sc.z) + sh.z);
      o[3] = (short)f2bf(v[k].w * rstd * (1.f + sc.w) + sh.w);
      *(bf16x4*)(H + (size_t)row * 2048 + c0) = o;
    }
  }
}

#ifndef REP_ML
#define REP_ML 1
#endif
DEV int lds_byte(int r, int c) {
  int st = (r >> 4) * 2 + (c >> 5), rr = r & 15, cc = c & 31, ob = rr * 64 + cc * 2;
  return st * 1024 + (ob ^ (((ob >> 9) & 1) << 5));
}
DEV void stage_rc(int b, int& R, int& C) {
  int st = b >> 10, sb = b & 1023, swz = sb ^ (((sb >> 9) & 1) << 5);
  R = (st >> 1) * 16 + (swz >> 6);
  C = (st & 1) * 32 + ((swz & 63) >> 1);
}
constexpr int STG = 49152;
template <int MODE>
DEV void gemm_tile(const Params& p, int l, int tm, int tn, char* smem) {
  int tid = threadIdx.x;
  asm volatile("" : "+v"(tid));
  const int lane = tid & 63, wave = tid >> 6, l15 = lane & 15, quad = lane >> 4;
  const int wm = wave >> 1, wn = wave & 1;
  constexpr int N = (MODE == 1) ? 6656 : 2048;
  const u16* A = (const u16*)(p.ws + (MODE == 1 ? OFF_H : OFF_Y));
  const u16* B = (const u16*)(p.ws + (MODE == 1 ? OFF_WINT : OFF_WOUTT)) + (size_t)l * N * 2048;
  const int m0 = tm * 256, n0 = tn * 128;
  int R0, C0, R1, C1;
  stage_rc(tid * 16, R0, C0);
  stage_rc(tid * 16 + 8192, R1, C1);
  const u16* gA0 = A + (size_t)(m0 + R0) * 2048 + C0;
  const u16* gA1 = A + (size_t)(m0 + R1) * 2048 + C1;
  const u16* gB0 = B + (size_t)(n0 + R0) * 2048 + C0;
  const u16* gB1 = B + (size_t)(n0 + R1) * 2048 + C1;
  char* lbase = smem + tid * 16;
  auto issue = [&](int kt, int st) {
    char* d = lbase + st * STG;
    const int ko = kt * 64;
    __builtin_amdgcn_global_load_lds((const unsigned*)(gA0 + ko), (__attribute__((address_space(3))) unsigned*)(d), 16, 0, 0);
    __builtin_amdgcn_global_load_lds((const unsigned*)(gA1 + ko), (__attribute__((address_space(3))) unsigned*)(d + 8192), 16, 0, 0);
    __builtin_amdgcn_global_load_lds((const unsigned*)(gA0 + 128 * 2048 + ko), (__attribute__((address_space(3))) unsigned*)(d + 16384), 16, 0, 0);
    __builtin_amdgcn_global_load_lds((const unsigned*)(gA1 + 128 * 2048 + ko), (__attribute__((address_space(3))) unsigned*)(d + 16384 + 8192), 16, 0, 0);
    __builtin_amdgcn_global_load_lds((const unsigned*)(gB0 + ko), (__attribute__((address_space(3))) unsigned*)(d + 32768), 16, 0, 0);
    __builtin_amdgcn_global_load_lds((const unsigned*)(gB1 + ko), (__attribute__((address_space(3))) unsigned*)(d + 32768 + 8192), 16, 0, 0);
  };
  int aoff[2][4], boff[2][4];
#pragma unroll
  for (int ks = 0; ks < 2; ks++)
#pragma unroll
    for (int i = 0; i < 4; i++) {
      aoff[ks][i] = (wm >> 1) * 16384 + lds_byte((wm & 1) * 64 + i * 16 + l15, ks * 32 + quad * 8);
      boff[ks][i] = 32768 + lds_byte(wn * 64 + i * 16 + l15, ks * 32 + quad * 8);
    }
  f32x4 acc[4][4];
#pragma unroll 1
  for (int rep = 0; rep < REP_ML; rep++) {
#pragma unroll
    for (int i = 0; i < 4; i++)
#pragma unroll
      for (int j = 0; j < 4; j++) acc[i][j] = (f32x4){0.f, 0.f, 0.f, 0.f};
    issue(0, 0);
    issue(1, 1);
    int st = 0;
#pragma unroll 1
    for (int kt = 0; kt < 32; kt++) {
      if (kt < 31) asm volatile("s_waitcnt vmcnt(6)" ::: "memory");
      else asm volatile("s_waitcnt vmcnt(0)" ::: "memory");
      __builtin_amdgcn_s_barrier();
      if (kt + 2 < 32) issue(kt + 2, st >= 1 ? st - 1 : 2);
      const char* sb = smem + st * STG;
#pragma unroll
      for (int ks = 0; ks < 2; ks++) {
        bf16x8 af[4], bfr[4];
#pragma unroll
        for (int i = 0; i < 4; i++) {
          af[i] = *(const bf16x8*)(sb + aoff[ks][i]);
          bfr[i] = *(const bf16x8*)(sb + boff[ks][i]);
        }
#pragma unroll
        for (int mt = 0; mt < 4; mt++)
#pragma unroll
          for (int nt = 0; nt < 4; nt++) acc[mt][nt] = mfma16(af[mt], bfr[nt], acc[mt][nt]);
      }
      st = st == 2 ? 0 : st + 1;
    }
    __builtin_amdgcn_s_barrier();
  }
  float* Cw = (float*)(smem + wave * 17408);
  const int rr = lane >> 3, c8 = (lane & 7) * 8;
  if (MODE == 1) {
    u16* P = (u16*)(p.ws + OFF_P);
    const int piece = n0 >> 9;
    const bool latent = m0 >= 4096;
    const float2* ROPE = (const float2*)(p.ws + OFF_ROPE);
#pragma unroll
    for (int mt = 0; mt < 4; mt++)
#pragma unroll
      for (int j = 0; j < 4; j++) {
        const int lr = mt * 16 + quad * 4 + j;
        float v0 = acc[mt][0][j], v1 = acc[mt][1][j], v2 = acc[mt][2][j], v3 = acc[mt][3][j];
        if (latent && (piece == 5 || piece == 6)) {
          const int t = (m0 + wm * 64 + lr - 4096) & 1023;
          float2 cr = ROPE[t * 32 + l15], cc = ROPE[t * 32 + 16 + l15];
          float a0 = v0 * cr.x - v1 * cr.y, a1 = v1 * cr.x + v0 * cr.y;
          float a2 = v2 * cc.x - v3 * cc.y, a3 = v3 * cc.x + v2 * cc.y;
          v0 = a0; v1 = a1; v2 = a2; v3 = a3;
        }
        float* cw = Cw + lr * 68 + l15;
        cw[0] = v0; cw[16] = v1; cw[32] = v2; cw[48] = v3;
      }
    const bool kvout = !latent && (piece == 6 || piece == 7);
#pragma unroll
    for (int ps = 0; ps < 8; ps++) {
      const int lr = ps * 8 + rr;
      const int row = m0 + wm * 64 + lr;
      const int col = n0 + wn * 64 + c8;
      float4 a = *(const float4*)(Cw + lr * 68 + c8), b4 = *(const float4*)(Cw + lr * 68 + c8 + 4);
      float f[8] = {a.x, a.y, a.z, a.w, b4.x, b4.y, b4.z, b4.w};
      *(bf16x8*)(P + (size_t)row * 6656 + col) = pack8(f);
      if (kvout) {
        const int bb = row >> 8, t = row & 255;
        float* o = p.out + (piece == 6 ? OUT_K : OUT_V) + ((size_t)((bb * 2 + l) * 256 + t)) * 512 + (col - piece * 512);
        *(float4*)o = a;
        *(float4*)(o + 4) = b4;
      }
    }
  } else {
    float* PRE = (float*)(p.ws + OFF_P);
    const float* MOD = (const float*)(p.ws + OFF_MOD);
    const float alpha = 1.41421356237f;
#pragma unroll
    for (int mt = 0; mt < 4; mt++)
#pragma unroll
      for (int j = 0; j < 4; j++) {
        float* cw = Cw + (mt * 16 + quad * 4 + j) * 68 + l15;
        cw[0] = acc[mt][0][j]; cw[16] = acc[mt][1][j]; cw[32] = acc[mt][2][j]; cw[48] = acc[mt][3][j];
      }
#pragma unroll
    for (int ps = 0; ps < 8; ps++) {
      const int lr = ps * 8 + rr;
      const int row = m0 + wm * 64 + lr;
      const int col = n0 + wn * 64 + c8;
      const int r = row < 4096 ? 0 : 1 + ((row - 4096) >> 10);
      const float* gate = MOD + (l * 5 + r) * 6144 + 4096 + col;
      const float* xr = ((l == 0) ? ((row < 4096) ? p.x_prompt + (size_t)row * 2048 : p.x_sample + (size_t)(row - 4096) * 2048)
                                  : p.out + (size_t)row * 2048) + col;
      const float* bo = p.b_out + l * 2048 + col;
      float* dst = PRE + (size_t)row * 2048 + col;
#pragma unroll
      for (int hh = 0; hh < 2; hh++) {
        float4 a = *(const float4*)(Cw + lr * 68 + c8 + hh * 4);
        float4 x4 = *(const float4*)(xr + hh * 4), g4 = *(const float4*)(gate + hh * 4), b4 = *(const float4*)(bo + hh * 4);
        float4 o4;
        o4.x = alpha * x4.x + g4.x * (a.x + b4.x);
        o4.y = alpha * x4.y + g4.y * (a.y + b4.y);
        o4.z = alpha * x4.z + g4.z * (a.z + b4.z);
        o4.w = alpha * x4.w + g4.w * (a.w + b4.w);
        *(float4*)(dst + hh * 4) = o4;
      }
    }
  }
  __builtin_amdgcn_s_waitcnt(0xc07f);
  __builtin_amdgcn_s_barrier();
}

template <int MODE>
DEV void phase_gemm(const Params& p, int l, int bid, int nb, char* smem) {
  constexpr int NT = (MODE == 1) ? 52 : 16;
  for (int t = bid; t < 32 * NT; t += nb) gemm_tile<MODE>(p, l, t & 31, t >> 5, smem);
}

DEV void mm128(const char* Al, const char* Bl, f32x4 (&acc)[2][8], int wave, int lane) {
  const int l15 = lane & 15, quad = lane >> 4, q4 = l15 >> 2, p4 = lane & 3;
  const unsigned bbase = (unsigned)(size_t)Bl + (quad * 8 + q4) * 288 + p4 * 8;
#pragma unroll
  for (int ks = 0; ks < 4; ks++) {
    bf16x8 a[2];
#pragma unroll
    for (int mt = 0; mt < 2; mt++) a[mt] = *(const bf16x8*)(Al + (wave * 32 + mt * 16 + l15) * 272 + ks * 64 + quad * 16);
#pragma unroll
    for (int nt = 0; nt < 8; nt++) {
      bf16x8 b = tr_read2(bbase + ks * 32 * 288 + nt * 32, bbase + ks * 32 * 288 + 4 * 288 + nt * 32);
#pragma unroll
      for (int mt = 0; mt < 2; mt++) acc[mt][nt] = mfma16(a[mt], b, acc[mt][nt]);
    }
  }
}

DEV void load_f32_tile_bf16(const float* src, char* dst, int stride_bytes) {
  const int tid = launder_tid();
#pragma unroll
  for (int i = 0; i < 8; i++) {
    int idx = tid + 256 * i, r = idx >> 4, c8 = idx & 15;
    float4 a = *(const float4*)(src + r * 128 + c8 * 8), b = *(const float4*)(src + r * 128 + c8 * 8 + 4);
    float f[8] = {a.x, a.y, a.z, a.w, b.x, b.y, b.z, b.w};
    *(bf16x8*)(dst + r * stride_bytes + c8 * 16) = pack8(f);
  }
}

DEV void gmlp_item(const Params& p, int l, int chunk, int g, char* smem) {
  char* Al = smem;
  char* Bl = smem + 34816;
  const int tid = launder_tid(), lane = tid & 63, wave = tid >> 6, l15 = lane & 15, quad = lane >> 4;
  const u16* P = (const u16*)(p.ws + OFF_P);
  u16* Y = (u16*)(p.ws + OFF_Y);
  const int r0 = chunk * 128;
  load_f32_tile_bf16(p.gmlp_w + (size_t)(l * 4 + g) * 16384, Al, 272);
#pragma unroll 1
  for (int rb = 0; rb < 4; rb++) {
    bf16x8 vv[8];
#pragma unroll
    for (int k = 0; k < 8; k++) vv[k] = *(const bf16x8*)(P + (size_t)(r0 + wave * 32 + rb * 8 + k) * 6656 + 512 + lane * 8);
#pragma unroll
    for (int k = 0; k < 8; k++) {
      const int j = wave * 32 + rb * 8 + k;
      float f[8];
      float sm1 = 0.f;
#pragma unroll
      for (int e = 0; e < 8; e++) { f[e] = bf2f(vv[k][e]); sm1 += f[e]; }
      const float mean = wave_sum(sm1) * (1.f / 512.f);
      float q = 0.f;
#pragma unroll
      for (int e = 0; e < 8; e++) { f[e] -= mean; q += f[e] * f[e]; }
      const float rstd = rsqrtf(wave_sum(q) * (1.f / 512.f) + 1e-6f);
      if (quad == g) {
#pragma unroll
        for (int e = 0; e < 8; e++) f[e] *= rstd;
        *(bf16x8*)(Bl + j * 288 + l15 * 16) = pack8(f);
      }
    }
  }
  __syncthreads();
  f32x4 acc[2][8];
#pragma unroll
  for (int i = 0; i < 2; i++)
#pragma unroll
    for (int j = 0; j < 8; j++) acc[i][j] = (f32x4){0.f, 0.f, 0.f, 0.f};
  mm128(Al, Bl, acc, wave, lane);
  __syncthreads();
  float* Ct = (float*)smem + wave * 32 * 132;
#pragma unroll
  for (int mt = 0; mt < 2; mt++)
#pragma unroll
    for (int nt = 0; nt < 8; nt++)
#pragma unroll
      for (int j = 0; j < 4; j++) Ct[(mt * 16 + quad * 4 + j) * 132 + nt * 16 + l15] = acc[mt][nt][j];
#pragma unroll 2
  for (int k = 0; k < 8; k++) {
    const int id = lane + 64 * k, r = id >> 4, c8 = (id & 15) * 8;
    const int i = wave * 32 + r;
    const float bs = p.gmlp_b[(l * 4 + g) * 128 + i];
    const u16* pr = P + (size_t)(r0 + i) * 6656 + g * 128 + c8;
    bf16x8 uv = *(const bf16x8*)pr;
    bf16x8 gv = *(const bf16x8*)(pr + 1024);
    float4 a0 = *(const float4*)(Ct + r * 132 + c8), a1 = *(const float4*)(Ct + r * 132 + c8 + 4);
    float av[8] = {a0.x, a0.y, a0.z, a0.w, a1.x, a1.y, a1.z, a1.w};
    float f[8];
#pragma unroll
    for (int e = 0; e < 8; e++) f[e] = silu(bf2f(gv[e])) * bf2f(uv[e]) * (av[e] + bs);
    *(bf16x8*)(Y + (size_t)(r0 + i) * 2048 + g * 128 + c8) = pack8(f);
  }
  __syncthreads();
}

DEV void pool_item(const Params& p, int l, int tile, int g, char* smem) {
  char* Sl = smem;
  char* Al = smem + 36864;
  const int tid = launder_tid(), lane = tid & 63, wave = tid >> 6, l15 = lane & 15, quad = lane >> 4;
  const u16* P = (const u16*)(p.ws + OFF_P);
  u16* Y = (u16*)(p.ws + OFF_Y);
  const int r0 = tile * 128;
  int s0, L;
  if (r0 < 4096) { s0 = r0 & ~255; L = 256; } else { s0 = 4096 + ((r0 - 4096) & ~1023); L = 1024; }
  const int w2 = 1 << g;
  for (int idx = tid; idx < 144 * 16; idx += 256) {
    int rr = idx >> 4, c8 = idx & 15;
    int row = r0 - 8 + rr;
    bf16x8 v = (bf16x8){0, 0, 0, 0, 0, 0, 0, 0};
    if (row >= s0 && row < s0 + L) v = *(const bf16x8*)(P + (size_t)row * 6656 + 3 * 512 + g * 128 + c8 * 8);
    *(bf16x8*)(Sl + rr * 256 + c8 * 16) = v;
  }
  __syncthreads();
#pragma unroll 1
  for (int i = 0; i < 8; i++) {
    int idx = tid + 256 * i, t = idx >> 4, c8 = idx & 15;
    int tl = r0 + t - s0;
    int lo = max(tl - w2, 0), hi = min(tl + w2, L);
    float s[8];
#pragma unroll
    for (int e = 0; e < 8; e++) s[e] = 0.f;
    for (int u = lo; u < hi; u++) {
      bf16x8 v = *(const bf16x8*)(Sl + (u - tl + t + 8) * 256 + c8 * 16);
#pragma unroll
      for (int e = 0; e < 8; e++) s[e] += bf2f(v[e]);
    }
    const float inv = 1.f / (float)(hi - lo);
    bf16x8 cv = *(const bf16x8*)(Sl + (t + 8) * 256 + c8 * 16);
#pragma unroll
    for (int e = 0; e < 8; e++) s[e] = s[e] * inv - bf2f(cv[e]);
    *(bf16x8*)(Al + t * 272 + c8 * 16) = pack8(s);
  }
  __syncthreads();
  load_f32_tile_bf16(p.pool_w + (size_t)(l * 4 + g) * 16384, Sl, 288);
  __syncthreads();
  f32x4 acc[2][8];
#pragma unroll
  for (int i = 0; i < 2; i++)
#pragma unroll
    for (int j = 0; j < 8; j++) acc[i][j] = (f32x4){0.f, 0.f, 0.f, 0.f};
  mm128(Al, Sl, acc, wave, lane);
  __syncthreads();
  float* Ct = (float*)smem + wave * 32 * 132;
#pragma unroll
  for (int mt = 0; mt < 2; mt++)
#pragma unroll
    for (int nt = 0; nt < 8; nt++)
#pragma unroll
      for (int j = 0; j < 4; j++) Ct[(mt * 16 + quad * 4 + j) * 132 + nt * 16 + l15] = acc[mt][nt][j];
#pragma unroll 2
  for (int k = 0; k < 8; k++) {
    const int id = lane + 64 * k, r = id >> 4, c8 = (id & 15) * 8;
    const int row = r0 + wave * 32 + r;
    bf16x8 gv = *(const bf16x8*)(P + (size_t)row * 6656 + 4 * 512 + g * 128 + c8);
    const float* psc = p.pool_scale + l * 512 + g * 128 + c8;
    float4 s0 = *(const float4*)psc, s1 = *(const float4*)(psc + 4);
    float sv[8] = {s0.x, s0.y, s0.z, s0.w, s1.x, s1.y, s1.z, s1.w};
    float4 a0 = *(const float4*)(Ct + r * 132 + c8), a1 = *(const float4*)(Ct + r * 132 + c8 + 4);
    float av[8] = {a0.x, a0.y, a0.z, a0.w, a1.x, a1.y, a1.z, a1.w};
    float f[8];
#pragma unroll
    for (int e = 0; e < 8; e++) f[e] = av[e] * sv[e] * silu(bf2f(gv[e]));
    *(bf16x8*)(Y + (size_t)row * 2048 + 512 + g * 128 + c8) = pack8(f);
  }
  __syncthreads();
}

DEV void attn_item(const Params& p, int l, int path, int b, int h, int qb, char* smem) {
  char* Kl = smem;
  char* Vl = smem + 17408;
  float* Ol = (float*)smem;
  const int tid = launder_tid(), lane = tid & 63, wave = tid >> 6, l15 = lane & 15, quad = lane >> 4;
  const int q4 = l15 >> 2, p4 = lane & 3;
  const u16* P = (const u16*)(p.ws + OFF_P);
  u16* Y = (u16*)(p.ws + OFF_Y);
  const int rowbase = path ? 4096 + b * 1024 : b * 256;
  const int nkeys = path ? 1536 : 256;
  const int ncache = path ? 512 : 0;
  const float* lq = p.lambda_qk + l * 256;
  const float d01 = wave_sum(lq[lane] * lq[64 + lane]);
  const float d23 = wave_sum(lq[128 + lane] * lq[192 + lane]);
  const float lam_init = 0.8f - 0.6f * expf(-0.3f * (float)l);
  const float lam = expf(d01) - expf(d23) + lam_init;
  bf16x8 qf[2][2];
  {
    const int qrow = rowbase + qb * 64 + wave * 16 + l15;
#pragma unroll
    for (int m = 0; m < 2; m++)
#pragma unroll
      for (int ks = 0; ks < 2; ks++) {
        bf16x8 v = *(const bf16x8*)(P + (size_t)qrow * 6656 + 5 * 512 + h * 128 + m * 64 + ks * 32 + quad * 8);
#pragma unroll
        for (int e = 0; e < 8; e++) v[e] = (short)f2bf(bf2f(v[e]) * 0.125f);
        qf[m][ks] = v;
      }
  }
  f32x4 o[2][8];
#pragma unroll
  for (int m = 0; m < 2; m++)
#pragma unroll
    for (int dt = 0; dt < 8; dt++) o[m][dt] = (f32x4){0.f, 0.f, 0.f, 0.f};
  float mrun[2] = {-1e30f, -1e30f}, lrun[2] = {0.f, 0.f};
  const unsigned vbase = (unsigned)(size_t)Vl + (quad * 4 + q4) * 288 + p4 * 8;
  const u16* KC = (const u16*)(p.ws + OFF_KC);
  const u16* VC = (const u16*)(p.ws + OFF_VC);
  const int ntile = nkeys >> 6;
  bf16x8 rk[4], rv[4];
  auto gload = [&](int t) {
    const int kt0 = t * 64;
#pragma unroll
    for (int i = 0; i < 4; i++) {
      const int chunk = tid + 256 * i, key = chunk >> 4, dc = chunk & 15;
      const int kg = kt0 + key;
      if (kt0 < ncache) {
        const size_t off = (((size_t)b * 2 + l) * 512 + kg) * 512 + h * 128 + dc * 8;
        rk[i] = *(const bf16x8*)(KC + off);
        rv[i] = *(const bf16x8*)(VC + off);
      } else {
        const size_t row = rowbase + (kg - ncache);
        rk[i] = *(const bf16x8*)(P + row * 6656 + 6 * 512 + h * 128 + dc * 8);
        rv[i] = *(const bf16x8*)(P + row * 6656 + 7 * 512 + h * 128 + dc * 8);
      }
    }
  };
  auto lstore = [&](int st) {
#pragma unroll
    for (int i = 0; i < 4; i++) {
      const int chunk = tid + 256 * i, key = chunk >> 4, dc = chunk & 15;
      *(bf16x8*)(Kl + st * 35840 + key * 272 + dc * 16) = rk[i];
      *(bf16x8*)(Vl + st * 35840 + key * 288 + dc * 16) = rv[i];
    }
  };
  __syncthreads();
  gload(0);
  lstore(0);
  if (ntile > 1) gload(1);
  __syncthreads();
#pragma unroll 1
  for (int t = 0; t < ntile; t++) {
    const int stg = t & 1;
    const char* Kc = Kl + stg * 35840;
    const unsigned vb = vbase + stg * 35840;
    if (t + 1 < ntile) {
      lstore(stg ^ 1);
      if (t + 2 < ntile) gload(t + 2);
    }
    __builtin_amdgcn_sched_barrier(0);
    f32x4 s[2][4];
#pragma unroll
    for (int m = 0; m < 2; m++)
#pragma unroll
      for (int kt = 0; kt < 4; kt++) {
        f32x4 a4 = (f32x4){0.f, 0.f, 0.f, 0.f};
#pragma unroll
        for (int ks = 0; ks < 2; ks++) {
          bf16x8 a = *(const bf16x8*)(Kc + (kt * 16 + l15) * 272 + m * 128 + ks * 64 + quad * 16);
          a4 = mfma16(a, qf[m][ks], a4);
        }
        s[m][kt] = a4;
      }
    bf16x8 pf[2][2];
#pragma unroll
    for (int m = 0; m < 2; m++) {
      float tmax = -1e30f;
#pragma unroll
      for (int kt = 0; kt < 4; kt++)
#pragma unroll
        for (int j = 0; j < 4; j++) tmax = fmaxf(tmax, s[m][kt][j]);
      tmax = fmaxf(tmax, __shfl_xor(tmax, 16));
      tmax = fmaxf(tmax, __shfl_xor(tmax, 32));
      const float mnew = fmaxf(mrun[m], tmax);
      const float alpha = __expf(mrun[m] - mnew);
      mrun[m] = mnew;
      float psum = 0.f;
#pragma unroll
      for (int kt = 0; kt < 4; kt++)
#pragma unroll
        for (int j = 0; j < 4; j++) {
          float pv = __expf(s[m][kt][j] - mnew);
          psum += pv;
          s[m][kt][j] = pv;
        }
      lrun[m] = lrun[m] * alpha + psum;
#pragma unroll
      for (int dt = 0; dt < 8; dt++) {
        o[m][dt][0] *= alpha; o[m][dt][1] *= alpha; o[m][dt][2] *= alpha; o[m][dt][3] *= alpha;
      }
#pragma unroll
      for (int kk = 0; kk < 2; kk++) {
        bf16x8 t;
#pragma unroll
        for (int j = 0; j < 4; j++) {
          t[j] = (short)f2bf(s[m][2 * kk][j]);
          t[4 + j] = (short)f2bf(s[m][2 * kk + 1][j]);
        }
        pf[m][kk] = t;
      }
    }
#pragma unroll
    for (int kk = 0; kk < 2; kk++)
#pragma unroll
      for (int dt = 0; dt < 8; dt++) {
        bf16x8 a = tr_read2(vb + (2 * kk) * 16 * 288 + dt * 32, vb + (2 * kk + 1) * 16 * 288 + dt * 32);
        o[0][dt] = mfma16(a, pf[0][kk], o[0][dt]);
        o[1][dt] = mfma16(a, pf[1][kk], o[1][dt]);
        if (dt & 1) __builtin_amdgcn_sched_barrier(0);
      }
    __syncthreads();
  }
  float l0 = lrun[0], l1 = lrun[1];
  l0 += __shfl_xor(l0, 16); l0 += __shfl_xor(l0, 32);
  l1 += __shfl_xor(l1, 16); l1 += __shfl_xor(l1, 32);
  const float i0 = 1.f / l0, i1 = lam / l1;
  float ss = 0.f;
#pragma unroll
  for (int dt = 0; dt < 8; dt++)
#pragma unroll
    for (int j = 0; j < 4; j++) {
      float v = o[0][dt][j] * i0 - o[1][dt][j] * i1;
      o[0][dt][j] = v;
      ss += v * v;
    }
  ss += __shfl_xor(ss, 16);
  ss += __shfl_xor(ss, 32);
  const float sc = rsqrtf(ss * (1.f / 128.f) + 1e-5f) * (1.f - lam_init);
  __syncthreads();
#pragma unroll
  for (int dt = 0; dt < 8; dt++)
#pragma unroll
    for (int j = 0; j < 4; j++) Ol[(wave * 16 + l15) * 132 + dt * 16 + quad * 4 + j] = o[0][dt][j] * sc;
  __syncthreads();
#pragma unroll
  for (int i = 0; i < 4; i++) {
    const int idx = tid + 256 * i, qr = idx >> 4, dc = idx & 15;
    const size_t row = rowbase + qb * 64 + qr;
    bf16x8 gv = *(const bf16x8*)(P + row * 6656 + 8 * 512 + h * 128 + dc * 8);
    float f[8];
#pragma unroll
    for (int e = 0; e < 8; e++) f[e] = Ol[qr * 132 + dc * 8 + e] * p.subln_w[l * 128 + dc * 8 + e] * silu(bf2f(gv[e]));
    *(bf16x8*)(Y + row * 2048 + 1024 + h * 128 + dc * 8) = pack8(f);
  }
  __syncthreads();
}

template <int L, int CG>
DEV void hyena_item(const Params& p, int l, int path, int b, int cgi, char* smem) {
  constexpr int ZLEN = L + 512;
  constexpr int XLEN = 2 * L + 16;
  constexpr int FBL = 2 * L + 32;
  constexpr int NG = L / 256;
  constexpr int NCH = CG / 8;
  u16* zb = (u16*)smem;
  u16* g1b = zb + CG * ZLEN;
  u16* fball = g1b + CG * L;
  const int tid = launder_tid(), lane = tid & 63, wave = tid >> 6, l15 = lane & 15, quad = lane >> 4;
  const u16* P = (const u16*)(p.ws + OFF_P);
  u16* Y = (u16*)(p.ws + OFF_Y);
  const int rowbase = path ? 4096 + b * 1024 : b * 256;
  const int c0 = cgi * CG;
  const float* cw = p.conv_w + l * 3 * 1536;
  const float* cb = p.conv_b + l * 1536;
  __syncthreads();
  for (int i = tid; i < CG * 512; i += 256) {
    int c = i >> 9, x = i & 511;
    zb[c * ZLEN + (x < 256 ? x : L + x)] = 0;
  }
  if (lane < 16) fball[wave * FBL + lane] = 0;
  constexpr int NREG = (XLEN / 8 + 63) / 64;
  constexpr int NQ = (CG / 4) * 2;
  const u16* Fg = (const u16*)(p.ws + (path ? OFF_F1 : OFF_F0));
  const float* FN = (const float*)(p.ws + OFF_FN);
  bf16x8 fr[NREG];
  float nrm_pf = 0.f, bias_pf = 0.f;
  auto fetch_filter = [&](int q) {
    const int chq = c0 + wave + 4 * (q >> 1), oq = q & 1;
    const u16* R = Fg + ((size_t)((l * 2 + oq) * 512 + chq)) * XLEN;
#pragma unroll
    for (int k = 0; k < NREG; k++) {
      const int i = lane + 64 * k;
      if (i < XLEN / 8) fr[k] = *(const bf16x8*)(R + i * 8);
    }
    nrm_pf = 0.f;
    if (lane < 2 * (L / 32)) nrm_pf = FN[((((path * 2 + l) * 4 + oq * 2 + (lane & 1)) * 32) + (lane >> 1)) * 512 + chq];
    bias_pf = p.hyena_bias[(l * 2 + oq) * 512 + chq];
  };
  fetch_filter(0);
#pragma unroll 2
  for (int idx = tid; idx < L * NCH; idx += 256) {
    const int t = idx / NCH, cc = idx - t * NCH;
    const int ch = c0 + cc * 8;
    float z[8], g1[8];
#pragma unroll
    for (int e = 0; e < 8; e++) { z[e] = cb[1024 + ch + e]; g1[e] = cb[ch + e]; }
#pragma unroll
    for (int dtp = 0; dtp < 3; dtp++) {
      const int tt = t + dtp - 1;
      if (tt >= 0 && tt < L) {
        const u16* pr = P + (size_t)(rowbase + tt) * 6656;
        bf16x8 xv = *(const bf16x8*)(pr + 9 * 512 + ch);
        bf16x8 hv = *(const bf16x8*)(pr + 11 * 512 + ch);
#pragma unroll
        for (int e = 0; e < 8; e++) {
          g1[e] += bf2f(xv[e]) * cw[dtp * 1536 + ch + e];
          z[e] += bf2f(hv[e]) * cw[dtp * 1536 + 1024 + ch + e];
        }
      }
    }
#pragma unroll
    for (int e = 0; e < 8; e++) {
      zb[(cc * 8 + e) * ZLEN + 256 + t] = f2bf(z[e]);
      g1b[(cc * 8 + e) * L + t] = f2bf(g1[e]);
    }
  }
  __syncthreads();
  u16* fb = fball + wave * FBL;
#pragma unroll 1
  for (int q = 0; q < NQ; q++) {
    const int cl = wave + 4 * (q >> 1);
    const int o = q & 1;
    u16* zc = zb + cl * ZLEN;
    {
#pragma unroll
      for (int k = 0; k < NREG; k++) {
        const int i = lane + 64 * k;
        if (i < XLEN / 8) *(bf16x8*)(fb + 16 + i * 8) = fr[k];
      }
      const float invn = 1.f / wave_sum(nrm_pf);
      const float bias = bias_pf;
      if (q + 1 < NQ) fetch_filter(q + 1);
      f32x4 acc[NG];
#pragma unroll
      for (int ng = 0; ng < NG; ng++) acc[ng] = (f32x4){0.f, 0.f, 0.f, 0.f};
      const int ebase = L - l15 + quad * 8 + 16;
#pragma unroll 2
      for (int u = -256; u <= L - 32; u += 32) {
        const bf16x8 bz = *(const bf16x8*)(zc + 256 + u + l15 * 16 + quad * 8);
#pragma unroll
        for (int ng = 0; ng < NG; ng++) {
          const int e0 = ebase - ng * 256 + u;
          const unsigned* fw = (const unsigned*)fb + (e0 >> 1);
          const unsigned sh = (e0 & 1) * 2;
          unsigned d0 = fw[0], d1 = fw[1], d2 = fw[2], d3 = fw[3], d4 = fw[4];
          union { unsigned u4[4]; bf16x8 v; } af;
          af.u4[0] = __builtin_amdgcn_alignbyte(d1, d0, sh);
          af.u4[1] = __builtin_amdgcn_alignbyte(d2, d1, sh);
          af.u4[2] = __builtin_amdgcn_alignbyte(d3, d2, sh);
          af.u4[3] = __builtin_amdgcn_alignbyte(d4, d3, sh);
          acc[ng] = mfma16(af.v, bz, acc[ng]);
        }
      }
#pragma unroll
      for (int ng = 0; ng < NG; ng++) {
        const int t = ng * 256 + l15 * 16 + quad * 4;
        bf16x4 zv = *(const bf16x4*)(zc + 256 + t);
        bf16x4 ov;
        if (o == 0) {
          bf16x4 gv = *(const bf16x4*)(g1b + cl * L + t);
#pragma unroll
          for (int j = 0; j < 4; j++) ov[j] = (short)f2bf(bf2f(gv[j]) * (acc[ng][j] * invn + bf2f(zv[j]) * bias));
        } else {
#pragma unroll
          for (int j = 0; j < 4; j++) ov[j] = (short)f2bf(acc[ng][j] * invn + bf2f(zv[j]) * bias);
        }
        *(bf16x4*)(zc + 256 + t) = ov;
      }
    }
  }
  __syncthreads();
#pragma unroll 2
  for (int idx = tid; idx < L * NCH; idx += 256) {
    const int t = idx / NCH, cc = idx - t * NCH;
    const int ch = c0 + cc * 8;
    float g2[8];
#pragma unroll
    for (int e = 0; e < 8; e++) g2[e] = cb[512 + ch + e];
#pragma unroll
    for (int dtp = 0; dtp < 3; dtp++) {
      const int tt = t + dtp - 1;
      if (tt >= 0 && tt < L) {
        bf16x8 xv = *(const bf16x8*)(P + (size_t)(rowbase + tt) * 6656 + 10 * 512 + ch);
#pragma unroll
        for (int e = 0; e < 8; e++) g2[e] += bf2f(xv[e]) * cw[dtp * 1536 + 512 + ch + e];
      }
    }
    bf16x8 dg = *(const bf16x8*)(P + (size_t)(rowbase + t) * 6656 + 12 * 512 + ch);
    float f[8];
#pragma unroll
    for (int e = 0; e < 8; e++) f[e] = bf2f((short)zb[(cc * 8 + e) * ZLEN + 256 + t]) * g2[e] * silu(bf2f(dg[e]));
    *(bf16x8*)(Y + (size_t)(rowbase + t) * 2048 + 1536 + ch) = pack8(f);
  }
  __syncthreads();
}

#ifndef R_HY
#define R_HY 1
#endif
#ifndef R_AT
#define R_AT 1
#endif
#ifndef R_GP
#define R_GP 1
#endif
DEV void phase_mix(const Params& p, int l, int bid, int nb, char* smem) {
  constexpr int N_HL = 256, N_AL = 256, N_HC = 512, N_AC = 256, N_G = 256, N_PL = 256;
  constexpr int TOT0 = N_HL + N_AL + N_HC + N_AC + N_G + N_PL;
  const int TOT = TOT0 + (l == 0 ? 1088 : 0);
  const int team = __builtin_amdgcn_readfirstlane(threadIdx.x >> 8);
  smem += team * LDS_TEAM;
  volatile LAS unsigned* stq = (volatile LAS unsigned*)(dyn_smem + LDS_MAIN);
  unsigned* cnt = (unsigned*)(p.ws + OFF_CNT) + 16 * (1 + l);
  for (;;) {
    __syncthreads();
    if (threadIdx.x == 0) stq[2] = atomicAdd(cnt, 1u);
    __syncthreads();
    const int jp = (int)stq[2];
    if (jp >= TOT / 2) break;
    int i = jp * 2 + team;
    if (i < N_HL) { for (int r = 0; r < R_HY; r++) hyena_item<1024, 8>(p, l, 1, i >> 6, i & 63, smem); continue; }
    i -= N_HL;
    if (i < N_AL) { for (int r = 0; r < R_AT; r++) attn_item(p, l, 1, i >> 6, (i >> 4) & 3, i & 15, smem); continue; }
    i -= N_AL;
    if (i < N_HC) { for (int r = 0; r < R_HY; r++) hyena_item<256, 16>(p, l, 0, i >> 5, i & 31, smem); continue; }
    i -= N_HC;
    if (i < N_AC) { for (int r = 0; r < R_AT; r++) attn_item(p, l, 0, i >> 4, (i >> 2) & 3, i & 3, smem); continue; }
    i -= N_AC;
    if (i < N_G) { for (int r = 0; r < R_GP; r++) gmlp_item(p, l, i >> 2, i & 3, smem); continue; }
    i -= N_G;
    if (i < N_PL) { for (int r = 0; r < R_GP; r++) pool_item(p, l, i >> 2, i & 3, smem); continue; }
    i -= N_PL;
    if (i < 832) {
      p0_transpose(p.w_in + (size_t)2048 * 6656, (u16*)(p.ws + OFF_WINT) + (size_t)6656 * 2048, 2048, 6656, i / 26, i % 26, smem);
    } else {
      i -= 832;
      p0_transpose(p.w_out + (size_t)2048 * 2048, (u16*)(p.ws + OFF_WOUTT) + (size_t)2048 * 2048, 2048, 2048, i / 8, i % 8, smem);
    }
  }
}


#ifndef REP_PREP
#define REP_PREP 1
#endif
#ifndef REP_ROWS
#define REP_ROWS 1
#endif
#ifndef REP_G1
#define REP_G1 1
#endif
#ifndef REP_MIX
#define REP_MIX 1
#endif
#ifndef REP_G2
#define REP_G2 1
#endif
__global__ void __launch_bounds__(512, 2) mega_kernel(Params p) {
  cg::grid_group grid = cg::this_grid();
  const int bid = blockIdx.x, nb = gridDim.x;
  volatile LAS unsigned* st = (volatile LAS unsigned*)(dyn_smem + LDS_MAIN);
  if (threadIdx.x < 4) st[threadIdx.x] = 0u;
  __syncthreads();
  XcdBarrier xb = xcd_barrier_post((unsigned*)(p.ws + OFF_BAR), st);
  if (p.out == nullptr) grid.sync();
#pragma unroll 1
  for (int r = 0; r < REP_PREP; r++) {
    phase_prep(p, bid, nb, dyn_smem);
    xcd_barrier(xb);
  }
#pragma unroll 1
  for (int l = 0; l < 2; l++) {
#pragma unroll 1
    for (int r = 0; r < REP_ROWS; r++) {
      phase_rows(p, l, l, bid, nb, dyn_smem);
      xcd_barrier(xb);
    }
#pragma unroll 1
    for (int r = 0; r < REP_G1; r++) {
      phase_gemm<1>(p, l, bid, nb, dyn_smem);
      xcd_barrier(xb);
    }
#pragma unroll 1
    for (int r = 0; r < REP_MIX; r++) {
      phase_mix(p, l, bid, nb, dyn_smem);
      xcd_barrier(xb);
    }
#pragma unroll 1
    for (int r = 0; r < REP_G2; r++) {
      phase_gemm<2>(p, l, bid, nb, dyn_smem);
      xcd_barrier(xb);
    }
  }
  phase_rows(p, 2, 1, bid, nb, dyn_smem);
}

extern "C" void kernel_launch(void* const* d_in, const int* in_sizes, int n_in, void* d_out, int out_size, void* d_ws,
                              size_t ws_size, hipStream_t stream) {
  static int grid_blocks = 0;
  if (!grid_blocks) {
    int dev = 0, cus = 0, per_cu = 0;
    (void)hipGetDevice(&dev);
    (void)hipDeviceGetAttribute(&cus, hipDeviceAttributeMultiprocessorCount, dev);
    (void)hipFuncSetAttribute((const void*)mega_kernel, hipFuncAttributeMaxDynamicSharedMemorySize, LDS_BYTES);
    (void)hipOccupancyMaxActiveBlocksPerMultiprocessor(&per_cu, mega_kernel, 512, LDS_BYTES);
    if (per_cu < 1) per_cu = 1;
    if (per_cu > 1) per_cu = 1;
    grid_blocks = cus * per_cu;
  }
  Params p{};
  const float** pp = (const float**)&p;
  for (int i = 0; i < 28; i++) pp[i] = (const float*)d_in[i];
  p.out = (float*)d_out;
  p.ws = (char*)d_ws;
  (void)hipMemsetAsync((char*)d_ws + OFF_BAR, 0, 16384, stream);
  void* args[] = {&p};
  hipError_t e = hipLaunchCooperativeKernel((const void*)mega_kernel, dim3(grid_blocks), dim3(512), args, LDS_BYTES, stream);
  if (e != hipSuccess) fprintf(stderr, "cooperative launch failed: %s (grid %d)\n", hipGetErrorString(e), grid_blocks);
}
```

```cpp
#include <hip/hip_runtime.h>
#include <hip/hip_cooperative_groups.h>
#include <cstdio>
namespace cg = cooperative_groups;

#ifndef COOP
#define COOP 1
#endif

typedef unsigned short u16;
typedef __attribute__((ext_vector_type(8))) short bf16x8;
typedef __attribute__((ext_vector_type(4))) short bf16x4;
typedef __attribute__((ext_vector_type(4))) float f32x4;

#define DEV __device__ __forceinline__

struct Params {
  const float *x_prompt, *x_sample, *cache_k, *cache_v, *c, *c_ctx, *w_mod, *b_mod, *w_in, *gmlp_w, *gmlp_b,
      *pool_w, *pool_scale, *lambda_qk, *subln_w, *conv_w, *conv_b, *filt_w1, *filt_b1, *filt_w2, *filt_b2,
      *filt_freq, *filt_w3, *hyena_bias, *w_out, *b_out, *ln_g, *ln_b;
  float* out;
  char* ws;
};

constexpr int LDS_TEAM = 73728;
constexpr int LDS_MAIN = 2 * LDS_TEAM;
constexpr int LDS_BYTES = LDS_MAIN + 16;
constexpr size_t OFF_WINT = 0;
constexpr size_t OFF_WOUTT = OFF_WINT + 54525952;
constexpr size_t OFF_H = OFF_WOUTT + 16777216;
constexpr size_t OFF_P = OFF_H + 33554432;
constexpr size_t OFF_Y = OFF_P + 109051904;
constexpr size_t OFF_MOD = OFF_Y + 33554432;
constexpr size_t OFF_F0 = OFF_MOD + 245760;
constexpr size_t OFF_F1 = OFF_F0 + 2162688;
constexpr size_t OFF_FN = OFF_F1 + 8454144;
constexpr size_t OFF_ROPE = OFF_FN + 1048576;
constexpr size_t OFF_BAR = OFF_ROPE + 262144;
constexpr size_t OFF_CNT = OFF_BAR + 13824;
constexpr size_t OFF_KC = OFF_BAR + 16384;
constexpr size_t OFF_VC = OFF_KC + 4194304;
constexpr size_t OUT_YS = 8388608;
constexpr size_t OUT_K = 16777216;
constexpr size_t OUT_V = 16777216 + 4194304;

DEV u16 f2bf(float f) {
  unsigned u = __float_as_uint(f);
  u += 0x7fffu + ((u >> 16) & 1u);
  return (u16)(u >> 16);
}
DEV float bf2f(short h) { return __uint_as_float(((unsigned)(u16)h) << 16); }
DEV float silu(float x) { return x / (1.f + __expf(-x)); }
DEV bf16x8 pack8(const float* f) {
  bf16x8 o;
#pragma unroll
  for (int j = 0; j < 8; j++) o[j] = (short)f2bf(f[j]);
  return o;
}
DEV f32x4 mfma16(bf16x8 a, bf16x8 b, f32x4 c) { return __builtin_amdgcn_mfma_f32_16x16x32_bf16(a, b, c, 0, 0, 0); }
DEV bf16x8 tr_read2(unsigned a0, unsigned a1) {
  bf16x4 lo, hi;
  asm volatile("ds_read_b64_tr_b16 %0, %2\n\tds_read_b64_tr_b16 %1, %3\n\ts_waitcnt lgkmcnt(0)"
               : "=&v"(lo), "=&v"(hi)
               : "v"(a0), "v"(a1)
               : "memory");
  bf16x8 r;
  r[0] = lo[0]; r[1] = lo[1]; r[2] = lo[2]; r[3] = lo[3];
  r[4] = hi[0]; r[5] = hi[1]; r[6] = hi[2]; r[7] = hi[3];
  return r;
}
DEV void tr_read2x4(unsigned a0, unsigned a1, unsigned step, bf16x8 (&r)[4]) {
  bf16x4 l0, h0, l1, h1, l2, h2, l3, h3;
  const unsigned b0 = a0 + step, c0 = a1 + step, b1 = a0 + 2 * step, c1 = a1 + 2 * step, b2 = a0 + 3 * step, c2 = a1 + 3 * step;
  asm volatile(
      "ds_read_b64_tr_b16 %0, %8\n\tds_read_b64_tr_b16 %1, %9\n\t"
      "ds_read_b64_tr_b16 %2, %10\n\tds_read_b64_tr_b16 %3, %11\n\t"
      "ds_read_b64_tr_b16 %4, %12\n\tds_read_b64_tr_b16 %5, %13\n\t"
      "ds_read_b64_tr_b16 %6, %14\n\tds_read_b64_tr_b16 %7, %15\n\ts_waitcnt lgkmcnt(0)"
      : "=&v"(l0), "=&v"(h0), "=&v"(l1), "=&v"(h1), "=&v"(l2), "=&v"(h2), "=&v"(l3), "=&v"(h3)
      : "v"(a0), "v"(a1), "v"(b0), "v"(c0), "v"(b1), "v"(c1), "v"(b2), "v"(c2)
      : "memory");
  r[0] = (bf16x8){l0[0], l0[1], l0[2], l0[3], h0[0], h0[1], h0[2], h0[3]};
  r[1] = (bf16x8){l1[0], l1[1], l1[2], l1[3], h1[0], h1[1], h1[2], h1[3]};
  r[2] = (bf16x8){l2[0], l2[1], l2[2], l2[3], h2[0], h2[1], h2[2], h2[3]};
  r[3] = (bf16x8){l3[0], l3[1], l3[2], l3[3], h3[0], h3[1], h3[2], h3[3]};
}
DEV int launder_tid() {
  int t = threadIdx.x & 255;
  asm volatile("" : "+v"(t));
  return t;
}
DEV float wave_sum(float v) {
#pragma unroll
  for (int o = 32; o; o >>= 1) v += __shfl_xor(v, o);
  return v;
}
DEV float block_sum(float v, float* red) {
  v = wave_sum(v);
  __syncthreads();
  if ((threadIdx.x & 63) == 0) red[threadIdx.x >> 6] = v;
  __syncthreads();
  return red[0] + red[1] + red[2] + red[3];
}


#define XB_TMO 128
#define XB_XCNT(j) (256 + 64 * (j))
#define XB_XSUB(j) (1280 + 64 * (j))
#define XB_XGEN(j) (2304 + 64 * (j))
#define XB_TOP 3328
#define XB_TOPGEN 3392
#define XCD_BAR_WORDS 3456
#define XB_SPIN_CAP (1u << 22)
#define LAS __attribute__((address_space(3)))
DEV unsigned xb_ld(unsigned* p) { return __hip_atomic_load(p, __ATOMIC_RELAXED, __HIP_MEMORY_SCOPE_AGENT); }
DEV unsigned xb_add(unsigned* p, unsigned v) { return __hip_atomic_fetch_add(p, v, __ATOMIC_RELAXED, __HIP_MEMORY_SCOPE_AGENT); }
DEV unsigned xb_xcc_id() { return (unsigned)__builtin_amdgcn_s_getreg((3 << 11) | 20) & 0xFu; }
#define XB_SPIN(cond, bar) do { unsigned _sp = 0; while (cond) { __builtin_amdgcn_s_sleep(1); \
    if ((++_sp & 255u) == 0u) { if (xb_ld(&(bar)[XB_TMO])) break; if (_sp > XB_SPIN_CAP) { atomicAdd(&(bar)[XB_TMO], 1u); break; } } } } while (0)
struct XcdBarrier { unsigned* bar; unsigned x; volatile LAS unsigned* st; };
DEV XcdBarrier xcd_barrier_post(unsigned* bar, volatile LAS unsigned* st) {
  XcdBarrier b; b.bar = bar; b.x = xb_xcc_id(); b.st = st;
  if (threadIdx.x == 0) (void)xb_add(&bar[XB_XCNT(b.x)], 1u);
  return b;
}
DEV void xcd_barrier_complete(unsigned* bar, unsigned x, unsigned& nloc, unsigned& nx) {
  const unsigned G = gridDim.x * gridDim.y * gridDim.z;
  unsigned sum, cnt, mine, sp = 0u;
  for (;;) {
    sum = 0u; cnt = 0u; mine = 0u;
#pragma unroll
    for (unsigned j = 0; j < 16; ++j) { const unsigned c = xb_ld(&bar[XB_XCNT(j)]); sum += c; cnt += (c > 0u) ? 1u : 0u; mine = (j == x) ? c : mine; }
    if (sum == G) break;
    __builtin_amdgcn_s_sleep(1);
    if ((++sp & 255u) == 0u) { if (xb_ld(&bar[XB_TMO])) break; if (sp > XB_SPIN_CAP) { atomicAdd(&bar[XB_TMO], 1u); break; } }
  }
  nloc = mine > 0u ? mine : 1u; nx = cnt > 0u ? cnt : 1u;
}
DEV void xcd_barrier(const XcdBarrier& b) {
  asm volatile("s_waitcnt vmcnt(0)" ::: "memory");
  __syncthreads();
  if (threadIdx.x == 0) {
    unsigned* bar = b.bar;
    __builtin_amdgcn_s_waitcnt(0);
    unsigned nloc = b.st[0], nx = b.st[1];
    if (nloc == 0u) { xcd_barrier_complete(bar, b.x, nloc, nx); b.st[0] = nloc; b.st[1] = nx; }
    const unsigned old = xb_add(&bar[XB_XSUB(b.x)], 1u);
    const unsigned gen = old / nloc;
    if (old + 1u == (gen + 1u) * nloc) {
      __builtin_amdgcn_fence(__ATOMIC_RELEASE, "agent");
      asm volatile("s_waitcnt vmcnt(0)" ::: "memory");
      const unsigned og = xb_add(&bar[XB_TOP], 1u);
      const unsigned tg = og / nx;
      if (og + 1u == (tg + 1u) * nx) xb_add(&bar[XB_TOPGEN], 1u);
      else XB_SPIN(xb_ld(&bar[XB_TOPGEN]) == tg, bar);
      __builtin_amdgcn_fence(__ATOMIC_ACQUIRE, "agent");
      xb_add(&bar[XB_XGEN(b.x)], 1u);
      asm volatile("s_waitcnt vmcnt(0)" ::: "memory");
    } else {
      XB_SPIN(xb_ld(&bar[XB_XGEN(b.x)]) == gen, bar);
      __builtin_amdgcn_fence(__ATOMIC_ACQUIRE, "agent");
      asm volatile("s_waitcnt vmcnt(0)" ::: "memory");
    }
  }
  __syncthreads();
}

extern __shared__ __attribute__((aligned(16))) char dyn_smem[];

DEV void p0_transpose(const float* __restrict__ W, u16* __restrict__ WT, int K, int N, int kt, int nt, char* smem) {
  float* sm = (float*)smem;
  const int tid = launder_tid();
  const int k0 = kt * 64, n0 = nt * 256;
  float4 v[16];
#pragma unroll
  for (int i = 0; i < 16; i++) {
    int r = (tid >> 6) + i * 4, c4 = tid & 63;
    v[i] = *(const float4*)(W + (size_t)(k0 + r) * N + n0 + c4 * 4);
  }
#pragma unroll
  for (int i = 0; i < 16; i++) {
    int r = (tid >> 6) + i * 4, c4 = tid & 63;
    float* d = sm + r * 257 + c4 * 4;
    d[0] = v[i].x; d[1] = v[i].y; d[2] = v[i].z; d[3] = v[i].w;
  }
  __syncthreads();
#pragma unroll
  for (int i = 0; i < 8; i++) {
    int ch = tid + i * 256, kc = ch & 7, n = ch >> 3;
    float f[8];
#pragma unroll
    for (int j = 0; j < 8; j++) f[j] = sm[(kc * 8 + j) * 257 + n];
    *(bf16x8*)(WT + (size_t)(n0 + n) * K + k0 + kc * 8) = pack8(f);
  }
  __syncthreads();
}

DEV void p0_mod(const Params& p, int l, int cgp, char* smem) {
  float* s = (float*)smem;
  float* red = s + 10240;
  const int tid = launder_tid();
  for (int i = tid; i < 10240; i += 256) {
    int r = i >> 11, k = i & 2047;
    float cv = (r == 0) ? p.c_ctx[k] : p.c[(r - 1) * 2048 + k];
    s[i] = cv / (1.f + expf(-cv));
  }
  __syncthreads();
  const int cq = tid & 15, ks = tid >> 4;
  const float* W = p.w_mod + (size_t)l * 2048 * 6144 + cgp * 64 + cq * 4;
  float acc[5][4];
#pragma unroll
  for (int r = 0; r < 5; r++)
#pragma unroll
    for (int e = 0; e < 4; e++) acc[r][e] = 0.f;
#pragma unroll 8
  for (int k = ks * 128; k < ks * 128 + 128; k++) {
    float4 w = *(const float4*)(W + (size_t)k * 6144);
#pragma unroll
    for (int r = 0; r < 5; r++) {
      float sv = s[r * 2048 + k];
      acc[r][0] += sv * w.x; acc[r][1] += sv * w.y; acc[r][2] += sv * w.z; acc[r][3] += sv * w.w;
    }
  }
#pragma unroll
  for (int r = 0; r < 5; r++)
#pragma unroll
    for (int e = 0; e < 4; e++) red[(ks * 5 + r) * 64 + cq * 4 + e] = acc[r][e];
  __syncthreads();
  float* MOD = (float*)(p.ws + OFF_MOD);
  for (int i = tid; i < 320; i += 256) {
    int r = i >> 6, col = i & 63;
    float sum = 0.f;
#pragma unroll
    for (int k2 = 0; k2 < 16; k2++) sum += red[(k2 * 5 + r) * 64 + col];
    sum += p.b_mod[l * 6144 + cgp * 64 + col];
    MOD[(l * 5 + r) * 6144 + cgp * 64 + col] = sum;
  }
  __syncthreads();
}

DEV void p0_filter(const Params& p, int l, int path, int chunk, int q, char* smem) {
  const int L = path ? 1024 : 256;
  const int XLEN = 2 * L + 16;
  float* w1s = (float*)smem;
  float* w2s = w1s + 2112;
  float* feats = w2s + 4096;
  float* h1 = feats + 1056;
  float* h2 = h1 + 2048;
  u16* tile = (u16*)smem;
  const int tid = launder_tid();
  const int o = q >> 1, dir = q & 1;
  float* b1 = h2 + 2048;
  float* b2 = b1 + 64;
  float* fr = b2 + 64;
  const float invLm1 = 1.f / (float)(L - 1);
  __syncthreads();
  if (tid < 64) { b1[tid] = p.filt_b1[l * 64 + tid]; b2[tid] = p.filt_b2[l * 64 + tid]; fr[tid] = p.filt_freq[l * 64 + tid]; }
  for (int i = tid; i < 2112; i += 256) w1s[i] = p.filt_w1[l * 2112 + i];
  for (int i = tid; i < 4096; i += 256) w2s[i] = p.filt_w2[l * 4096 + i];
  for (int e = tid; e < 1056; e += 256) {
    int t = e / 33, f = e - t * 33;
    int tg = chunk * 32 + t;
    float v;
    if (f == 0) v = (float)tg * invLm1;
    else {
      int bb = (f - 1) & 15;
      float band = 1e-4f + (float)bb * ((15.f - 1e-4f) / 15.f);
      float ang = (6.283185307179586f * (float)tg / (float)L) * band;
      v = (f <= 16) ? cosf(ang) : sinf(ang);
    }
    feats[e] = v;
  }
  __syncthreads();
  {
    int t = tid >> 3, j0 = (tid & 7) * 8;
    float a[8];
#pragma unroll
    for (int k = 0; k < 8; k++) a[k] = b1[j0 + k];
#pragma unroll 3
    for (int f = 0; f < 33; f++) {
      float fv = feats[t * 33 + f];
#pragma unroll
      for (int k = 0; k < 8; k++) a[k] += fv * w1s[f * 64 + j0 + k];
    }
#pragma unroll
    for (int k = 0; k < 8; k++) h1[t * 64 + j0 + k] = sinf(fr[j0 + k] * a[k]);
  }
  __syncthreads();
  {
    int t = tid >> 3, j0 = (tid & 7) * 8;
    float a[8];
#pragma unroll
    for (int k = 0; k < 8; k++) a[k] = b2[j0 + k];
#pragma unroll 4
    for (int f = 0; f < 64; f++) {
      float fv = h1[t * 64 + f];
#pragma unroll
      for (int k = 0; k < 8; k++) a[k] += fv * w2s[f * 64 + j0 + k];
    }
#pragma unroll
    for (int k = 0; k < 8; k++) h2[t * 64 + j0 + k] = sinf(fr[j0 + k] * a[k]);
  }
  __syncthreads();
  const float da = logf(1e-2f) / 0.3f, db = logf(1e-2f) / 1.5f;
  float* FNP = (float*)(p.ws + OFF_FN);
#pragma unroll 1
  for (int cc = 0; cc < 2; cc++) {
    const int ch = tid + cc * 256;
    const float* w3 = p.filt_w3 + (size_t)l * 64 * 2048 + q * 512 + ch;
    float w3r[64];
#pragma unroll
    for (int j = 0; j < 64; j++) w3r[j] = w3[j * 2048];
    const float delta = fabsf(da + (db - da) * ((float)ch / 511.f));
    float asum = 0.f;
#pragma unroll 2
    for (int t = 0; t < 32; t++) {
      const int tg = chunk * 32 + t;
      float acc = 0.f;
      int toff = t * 64;
      asm volatile("" : "+v"(toff));
      const float* hp = h2 + toff;
#pragma unroll
      for (int j4 = 0; j4 < 16; j4++) {
        float4 hv = *(const float4*)(hp + j4 * 4);
        acc += hv.x * w3r[j4 * 4] + hv.y * w3r[j4 * 4 + 1] + hv.z * w3r[j4 * 4 + 2] + hv.w * w3r[j4 * 4 + 3];
      }
      float v = acc * expf(-(float)tg * invLm1 * delta);
      if (dir == 0 || tg >= 1) asum += fabsf(v);
      tile[ch * 34 + t] = f2bf(v);
    }
    FNP[((((path * 2 + l) * 4 + q) * 32) + chunk) * 512 + ch] = asum;
  }
  __syncthreads();
  u16* Fb = (u16*)(p.ws + (path ? OFF_F1 : OFF_F0));
  {
    const int hw = tid >> 5, t = tid & 31;
    const int tg = chunk * 32 + t;
    const int x = dir ? L + tg : L - tg;
    const bool ok = (dir == 0) || (tg >= 1);
    for (int ch = hw; ch < 512; ch += 8) {
      if (ok) Fb[((size_t)((l * 2 + o) * 512 + ch)) * XLEN + x] = tile[ch * 34 + t];
    }
  }
  if (chunk == 0) {
    if (dir == 0) {
      for (int ch = tid; ch < 512; ch += 256) Fb[((size_t)((l * 2 + o) * 512 + ch)) * XLEN] = 0;
    } else {
      for (int e = tid; e < 512 * 16; e += 256) Fb[((size_t)((l * 2 + o) * 512 + (e >> 4))) * XLEN + 2 * L + (e & 15)] = 0;
    }
  }
  __syncthreads();
}

DEV void p0_rope(const Params& p, int item) {
  int idx = item * 256 + (threadIdx.x & 255);
  int t = idx >> 5, f = idx & 31;
  int fi = f & 15;
  float inv = powf(10000.f, -(float)(2 * fi) / 32.f);
  float pos = (f < 16) ? (float)(t >> 6) : (float)(t & 63);
  float ang = pos * inv;
  float2 cs;
  cs.x = cosf(ang);
  cs.y = sinf(ang);
  ((float2*)(p.ws + OFF_ROPE))[idx] = cs;
}

DEV void phase_prep(const Params& p, int bid, int nb, char* smem) {
  constexpr int N_MOD = 192, N_FILT = 320, N_TIN = 832, N_TOUT = 256, N_ROPE = 128, N_CVT = 512;
  constexpr int TOT = N_MOD + N_FILT + N_TIN + N_TOUT + N_ROPE + N_CVT;
  const int team = __builtin_amdgcn_readfirstlane(threadIdx.x >> 8);
  smem += team * LDS_TEAM;
  volatile LAS unsigned* stq = (volatile LAS unsigned*)(dyn_smem + LDS_MAIN);
  unsigned* cnt = (unsigned*)(p.ws + OFF_CNT);
  for (;;) {
    __syncthreads();
    if (threadIdx.x == 0) stq[2] = atomicAdd(cnt, 1u);
    __syncthreads();
    const int jp = (int)stq[2];
    if (jp >= TOT / 2) break;
    int i = jp * 2 + team;
    if (i < N_MOD) { p0_mod(p, i / 96, i % 96, smem); continue; }
    i -= N_MOD;
    if (i < N_FILT) {
      if (i < 256) p0_filter(p, i >> 7, 1, (i >> 2) & 31, i & 3, smem);
      else { int k = i - 256; p0_filter(p, k >> 5, 0, (k >> 2) & 7, k & 3, smem); }
      continue;
    }
    i -= N_FILT;
    if (i < N_TIN) {
      int nt = i % 26, kt = i / 26;
      p0_transpose(p.w_in, (u16*)(p.ws + OFF_WINT), 2048, 6656, kt, nt, smem);
      continue;
    }
    i -= N_TIN;
    if (i < N_TOUT) {
      int nt = i % 8, kt = i / 8;
      p0_transpose(p.w_out, (u16*)(p.ws + OFF_WOUTT), 2048, 2048, kt, nt, smem);
      continue;
    }
    i -= N_TOUT;
    if (i < N_ROPE) { p0_rope(p, i); continue; }
    i -= N_ROPE;
    {
      const float* src = (i < 256) ? p.cache_k : p.cache_v;
      u16* dst = (u16*)(p.ws + ((i < 256) ? OFF_KC : OFF_VC));
      const int tl = threadIdx.x & 255;
      const size_t base = (size_t)(i & 255) * 8192;
#pragma unroll
      for (int e = 0; e < 4; e++) {
        const size_t o = base + (size_t)(e * 256 + tl) * 8;
        float4 a = *(const float4*)(src + o), c2 = *(const float4*)(src + o + 4);
        float f[8] = {a.x, a.y, a.z, a.w, c2.x, c2.y, c2.z, c2.w};
        *(bf16x8*)(dst + o) = pack8(f);
      }
    }
  }
}

DEV void phase_rows(const Params& p, int mode, int l, int bid, int nb, char* smem) {
  int tr0 = threadIdx.x;
  asm volatile("" : "+v"(tr0));
  const int lane = tr0 & 63, wave = tr0 >> 6;
  const float* MOD = (const float*)(p.ws + OFF_MOD);
  const float* PRE = (const float*)(p.ws + OFF_P);
  u16* H = (u16*)(p.ws + OFF_H);
  for (int row = bid * 8 + wave; row < 8192; row += nb * 8) {
    float4 v[8];
    if (mode == 0) {
      const float* src = (row < 4096) ? p.x_prompt + (size_t)row * 2048 : p.x_sample + (size_t)(row - 4096) * 2048;
#pragma unroll
      for (int k = 0; k < 8; k++) v[k] = *(const float4*)(src + k * 256 + lane * 4);
    } else {
      const u16* src = (const u16*)PRE + (size_t)row * 2048;
#pragma unroll
      for (int k = 0; k < 8; k++) {
        bf16x4 h4 = *(const bf16x4*)(src + k * 256 + lane * 4);
        v[k] = make_float4(bf2f(h4[0]), bf2f(h4[1]), bf2f(h4[2]), bf2f(h4[3]));
      }
    }
    if (mode != 0) {
      const int lp = (mode == 1) ? l - 1 : 1;
      float s = 0.f;
#pragma unroll
      for (int k = 0; k < 8; k++) s += v[k].x + v[k].y + v[k].z + v[k].w;
      const float mean = wave_sum(s) * (1.f / 2048.f);
      float q = 0.f;
#pragma unroll
      for (int k = 0; k < 8; k++) {
        v[k].x -= mean; v[k].y -= mean; v[k].z -= mean; v[k].w -= mean;
        q += v[k].x * v[k].x + v[k].y * v[k].y + v[k].z * v[k].z + v[k].w * v[k].w;
      }
      const float rstd = rsqrtf(wave_sum(q) * (1.f / 2048.f) + 1e-6f);
      const float* g = p.ln_g + lp * 2048;
      const float* bb = p.ln_b + lp * 2048;
#pragma unroll
      for (int k = 0; k < 8; k++) {
        const int c0 = k * 256 + lane * 4;
        float4 g4 = *(const float4*)(g + c0), b4 = *(const float4*)(bb + c0);
        v[k].x = v[k].x * rstd * g4.x + b4.x; v[k].y = v[k].y * rstd * g4.y + b4.y;
        v[k].z = v[k].z * rstd * g4.z + b4.z; v[k].w = v[k].w * rstd * g4.w + b4.w;
        *(float4*)(p.out + (size_t)row * 2048 + c0) = v[k];
      }
      if (mode == 2) continue;
    }
    float s = 0.f;
#pragma unroll
    for (int k = 0; k < 8; k++) s += v[k].x + v[k].y + v[k].z + v[k].w;
    const float mean = wave_sum(s) * (1.f / 2048.f);
    float q = 0.f;
#pragma unroll
    for (int k = 0; k < 8; k++) {
      v[k].x -= mean; v[k].y -= mean; v[k].z -= mean; v[k].w -= mean;
      q += v[k].x * v[k].x + v[k].y * v[k].y + v[k].z * v[k].z + v[k].w * v[k].w;
    }
    const float rstd = rsqrtf(wave_sum(q) * (1.f / 2048.f) + 1e-6f);
    const int r = row < 4096 ? 0 : 1 + ((row - 4096) >> 10);
    const float* md = MOD + (l * 5 + r) * 6144;
#pragma unroll
    for (int k = 0; k < 8; k++) {
      const int c0 = k * 256 + lane * 4;
      float4 sh = *(const float4*)(md + c0), sc = *(const float4*)(md + 2048 + c0);
      bf16x4 o;
      o[0] = (short)f2bf(v[k].x * rstd * (1.f + sc.x) + sh.x);
      o[1] = (short)f2bf(v[k].y * rstd * (1.f + sc.y) + sh.y);
      o[2] = (short)f2bf(v[k].z * rstd * (1.f + sc.z) + sh.z);
      o[3] = (short)f2bf(v[k].w * rstd * (1.f + sc.w) + sh.w);
      *(bf16x4*)(H + (size_t)row * 2048 + c0) = o;
    }
  }
}


namespace pg8 {
#define PG8_LAS __attribute__((address_space(3)))
typedef unsigned short bf16_t;
typedef short bf16x8 __attribute__((ext_vector_type(8)));
typedef float f32x4 __attribute__((ext_vector_type(4)));
typedef unsigned u32x4 __attribute__((ext_vector_type(4)));
constexpr int BM = 256, BK = 64, HALF = 128, HTB = HALF * BK * 2  , STAGE_BYTES = 8 * HTB, NXCD = 8, WGM = 8;

__host__ __device__ __forceinline__ int lds_byte(int r, int c) { const int st = (r >> 4) * 2 + (c >> 5), rr = r & 15, cc = c & 31, ob = rr * 64 + cc * 2; return st * 1024 + (ob ^ (((ob >> 9) & 1) << 5)); }
__host__ __device__ __forceinline__ void stage_rc(int b, int& R, int& C) { const int st = b / 1024, sb = b % 1024, swz = sb ^ (((sb >> 9) & 1) << 5); R = (st >> 1) * 16 + swz / 64; C = (st & 1) * 32 + (swz % 64) / 2; }
__host__ __device__ __forceinline__ int perm32(int rho) { const int n = rho >> 4, i = rho & 15; return 8 * (i >> 2) + 4 * n + (i & 3); }

struct Unit { int pm, pn; };
struct Gemm { const bf16_t* A; const bf16_t* Bt; int M, N, K; };

struct StaticOrder {
    int nM, nN, nwg, G, c;
    __host__ __device__ void init(int M, int N, int G_, int c_) { nM = M / BM; nN = N / BM; nwg = nM * nN; G = G_; c = c_; }
    __host__ __device__ bool next(int i, Unit& u) const {
        const long L = (long)i * G + c; if (L >= nwg) return false;
        int wgid = (int)L; { const int q = nwg / NXCD, r = nwg % NXCD, xcd = wgid % NXCD, off = wgid / NXCD; wgid = (xcd < r ? xcd * (q + 1) : r * (q + 1) + (xcd - r) * q) + off; }
        const int nig = WGM * nN, gid = wgid / nig, fm = gid * WGM, gsz = (nM - fm) < WGM ? (nM - fm) : WGM;
        u.pm = fm + ((wgid % nig) % gsz); u.pn = (wgid % nig) / gsz; return true;
    }
    __device__ __forceinline__ void a_ready(const Unit&) const {}
    __device__ __forceinline__ void done(const Unit&) const {}
};

__device__ __forceinline__ unsigned cvt_pk_bf16(float lo, float hi) { unsigned r; asm volatile("v_cvt_pk_bf16_f32 %0, %1, %2" : "=v"(r) : "v"(lo), "v"(hi)); return r; }


template <class Epi, class Sched, bool STAMP = false>
__device__ __forceinline__ void gemm_phase(PG8_LAS unsigned char* lds, const Gemm g, const Sched& S, const Epi& E, unsigned long long* stamps) {
    int tid0 = threadIdx.x; asm volatile("" : "+v"(tid0));
    const int tid = tid0, wid = __builtin_amdgcn_readfirstlane(tid >> 6), lane = tid & 63, wr = wid >> 2, wc = wid & 3, fr = lane & 15, fq = lane >> 4;
    const int K = g.K, nt = K / BK;
    int ts_lo = 0, ts_hi = 0, nts = 0; const unsigned long long rt_entry = STAMP ? (unsigned long long)wall_clock64() : 0ull;
#define PG8_STAMP() do { if (STAMP && wid == 0 && nts < 64) { const unsigned long long _c = (unsigned long long)clock64(); \
        ts_lo = (lane == nts) ? (int)(unsigned)_c : ts_lo; ts_hi = (lane == nts) ? (int)(unsigned)(_c >> 32) : ts_hi; ++nts; } } while (0)
    PG8_STAMP();
    unsigned voffA[2], voffB[2];
#pragma unroll
    for (int i = 0; i < 2; ++i) { int R, C; stage_rc(tid * 16 + i * 8192, R, C); const int Rb = Epi::PERM ? ((R & ~31) + perm32(R & 31)) : R;
        voffA[i] = (unsigned)(R * K + C) * 2u; voffB[i] = (unsigned)(Rb * K + C) * 2u; }
    const size_t kstep = (size_t)(BK * 2);
    const size_t hstep = (size_t)HALF * K * 2;
    const size_t tstep = 2 * hstep;
    const unsigned ldsw = (unsigned)wid * 1024u;
    const int aoff = lds_byte(wr * 64 + fr, fq * 8), boff = lds_byte(wc * 32 + fr, fq * 8);
#define PG8_SA(b, h) (((b) * 2 + (h)) * HTB)
#define PG8_SB(b, h) ((4 + (b) * 2 + (h)) * HTB)
#define PG8_STAGE(bufoff, gbase, voff) do { _Pragma("unroll") for (int _i = 0; _i < 2; ++_i) \
        __builtin_amdgcn_global_load_lds((const unsigned*)((const char*)(gbase) + (voff)[_i]), (PG8_LAS unsigned*)(lds + (bufoff) + ldsw + _i * 8192), 16, 0, 0); } while (0)
#define PG8_LDA(dst, b, h) do { _Pragma("unroll") for (int m = 0; m < 4; ++m) _Pragma("unroll") for (int k = 0; k < 2; ++k) dst[m][k] = *(const PG8_LAS bf16x8*)(lds + PG8_SA(b, h) + aoff + m * 2048 + k * 1024); } while (0)
#define PG8_LDB(dst, b, h) do { _Pragma("unroll") for (int n = 0; n < 2; ++n) _Pragma("unroll") for (int k = 0; k < 2; ++k) dst[n][k] = *(const PG8_LAS bf16x8*)(lds + PG8_SB(b, h) + boff + n * 2048 + k * 1024); } while (0)
#define PG8_MMA(ai, bj, At, Bt) do { __builtin_amdgcn_s_setprio(1); _Pragma("unroll") for (int m = 0; m < 4; ++m) _Pragma("unroll") for (int n = 0; n < 2; ++n) _Pragma("unroll") for (int k = 0; k < 2; ++k) \
        acc[ai][bj][m][n] = __builtin_amdgcn_mfma_f32_16x16x32_bf16(Bt[n][k], At[m][k], acc[ai][bj][m][n], 0, 0, 0); __builtin_amdgcn_s_setprio(0); } while (0)
#define PG8_WAIT_V(n) asm volatile("s_waitcnt vmcnt(" #n ")" ::: "memory")
#define PG8_WAIT_L(n) asm volatile("s_waitcnt lgkmcnt(" #n ")" ::: "memory")
#define PG8_BAR __builtin_amdgcn_s_barrier()
#define PG8_SCHED __builtin_amdgcn_sched_barrier(0)
    Unit cur, nxt; int ui = 0;
    if (!S.next(0, cur)) return;
    f32x4 acc[2][2][4][2];
#pragma unroll
    for (int a = 0; a < 2; ++a)
#pragma unroll
        for (int b = 0; b < 2; ++b)
#pragma unroll
            for (int m = 0; m < 4; ++m)
#pragma unroll
                for (int n = 0; n < 2; ++n) acc[a][b][m][n] = (f32x4){0.f, 0.f, 0.f, 0.f};
    bf16x8 At[4][2], B0[2][2], B1[2][2];
    const char* cA = (const char*)g.A + (size_t)cur.pm * tstep; const char* cB = (const char*)g.Bt + (size_t)cur.pn * tstep;
    S.a_ready(cur);
    PG8_STAGE(PG8_SB(0, 0), cB, voffB); PG8_STAGE(PG8_SA(0, 0), cA, voffA); PG8_STAGE(PG8_SB(0, 1), cB + hstep, voffB); PG8_STAGE(PG8_SA(0, 1), cA + hstep, voffA);
    if (wr == 1) PG8_BAR;
    PG8_WAIT_V(4); PG8_BAR;
    PG8_STAGE(PG8_SB(1, 0), cB + kstep, voffB); PG8_STAGE(PG8_SA(1, 0), cA + kstep, voffA); PG8_STAGE(PG8_SB(1, 1), cB + hstep + kstep, voffB);
    PG8_WAIT_V(6); PG8_BAR;
    PG8_STAMP();
    for (;;) {
        const bool has_next = S.next(ui + 1, nxt);
        const char* nA = has_next ? (const char*)g.A + (size_t)nxt.pm * tstep : cA; const char* nB = has_next ? (const char*)g.Bt + (size_t)nxt.pn * tstep : cB;
        for (int t = 0; t < nt; t += 2) {
            const bool last = (t == nt - 2);
            const char* a1 = cA + (size_t)(t + 1) * kstep;
            const char* a2 = last ? nA : cA + (size_t)(t + 2) * kstep; const char* b2 = last ? nB : cB + (size_t)(t + 2) * kstep;
            const char* a3 = a2 + kstep; const char* b3 = b2 + kstep;
            if (last && has_next) S.a_ready(nxt);
            PG8_LDB(B0, 0, 0); PG8_SCHED; PG8_LDA(At, 0, 0); PG8_STAGE(PG8_SA(1, 1), a1 + hstep, voffA);
            PG8_WAIT_L(8); PG8_BAR; PG8_WAIT_L(0); PG8_MMA(0, 0, At, B0); PG8_BAR; PG8_SCHED;
            PG8_LDB(B1, 0, 1); PG8_STAGE(PG8_SB(0, 0), b2, voffB);
            PG8_BAR; PG8_WAIT_L(0); PG8_MMA(0, 1, At, B1); PG8_BAR;
            PG8_LDA(At, 0, 1); PG8_STAGE(PG8_SA(0, 0), a2, voffA);
            PG8_BAR; PG8_WAIT_L(0); PG8_MMA(1, 0, At, B0); PG8_BAR; PG8_SCHED;
            PG8_STAGE(PG8_SB(0, 1), b2 + hstep, voffB);
            PG8_WAIT_V(6); PG8_BAR; PG8_MMA(1, 1, At, B1); PG8_BAR;
            PG8_LDB(B0, 1, 0); PG8_SCHED; PG8_LDA(At, 1, 0); PG8_STAGE(PG8_SA(0, 1), a2 + hstep, voffA);
            PG8_WAIT_L(8); PG8_BAR; PG8_WAIT_L(0); PG8_MMA(0, 0, At, B0); PG8_BAR; PG8_SCHED;
            PG8_LDB(B1, 1, 1); PG8_STAGE(PG8_SB(1, 0), b3, voffB);
            PG8_BAR; PG8_WAIT_L(0); PG8_MMA(0, 1, At, B1); PG8_BAR;
            PG8_LDA(At, 1, 1); PG8_STAGE(PG8_SA(1, 0), a3, voffA);
            PG8_BAR; PG8_WAIT_L(0); PG8_MMA(1, 0, At, B0); PG8_BAR; PG8_SCHED;
            PG8_STAGE(PG8_SB(1, 1), b3 + hstep, voffB);
            PG8_WAIT_V(6); PG8_BAR; PG8_MMA(1, 1, At, B1); PG8_BAR;
        }
        PG8_STAMP();
        if constexpr (!Epi::AFTER_DRAIN) { E(acc, cur, wr, wc, fr, fq); S.done(cur); }
        PG8_STAMP();
        if (!has_next) break;
#pragma unroll
        for (int a = 0; a < 2; ++a)
#pragma unroll
            for (int b = 0; b < 2; ++b)
#pragma unroll
                for (int m = 0; m < 4; ++m)
#pragma unroll
                    for (int n = 0; n < 2; ++n) acc[a][b][m][n] = (f32x4){0.f, 0.f, 0.f, 0.f};
        cur = nxt; cA = nA; cB = nB; ++ui;
    }
    PG8_WAIT_V(0);
    if (wr == 0) PG8_BAR;
    PG8_BAR;
    if constexpr (Epi::AFTER_DRAIN) { E.fused(acc, cur, wr, wc, fr, fq, lds, wid, lane); S.done(cur); }
    PG8_STAMP();
    if (STAMP && wid == 0) { stamps[lane] = lane < nts ? (((unsigned long long)(unsigned)ts_hi << 32) | (unsigned)ts_lo) : 0ull;
        if (lane == 62) stamps[62] = rt_entry; if (lane == 63) stamps[63] = (unsigned long long)wall_clock64(); }
#undef PG8_STAMP
#undef PG8_SA
#undef PG8_SB
#undef PG8_STAGE
#undef PG8_LDA
#undef PG8_LDB
#undef PG8_MMA
#undef PG8_WAIT_V
#undef PG8_WAIT_L
#undef PG8_BAR
#undef PG8_SCHED
}
}

struct EpiG1 {
  static constexpr bool PERM = true, AFTER_DRAIN = false;
  u16* P; float* out; const float2* ROPE; int l; int colbase;
  __device__ __forceinline__ void operator()(const pg8::f32x4 (&acc)[2][2][4][2], const pg8::Unit& u, int wr, int wc, int fr, int fq) const {
    const int piece = (colbase + u.pn * 256) >> 9;
    const bool latent = u.pm >= 16;
    const bool rope = latent && (piece == 5 || piece == 6);
    const bool kvout = !latent && (piece == 6 || piece == 7);
    const int row0 = u.pm * 256 + wr * 64 + fr, col0 = colbase + u.pn * 256 + wc * 32 + 8 * fq;
    const bool hi = fq >= 2;
#pragma unroll
    for (int ai = 0; ai < 2; ++ai)
#pragma unroll
      for (int mp = 0; mp < 2; ++mp) {
      float4 csb[2][4];
      if (rope) {
#pragma unroll
        for (int mm = 0; mm < 2; ++mm) {
          const int t = (row0 + ai * 128 + (mp * 2 + mm) * 16 - 4096) & 1023;
          const float4* rp = (const float4*)(ROPE + t * 32 + (wc & 1) * 16 + 8 * (fq & 1));
          csb[mm][0] = rp[0]; csb[mm][1] = rp[1]; csb[mm][2] = rp[2]; csb[mm][3] = rp[3];
        }
      }
#pragma unroll
      for (int mm = 0; mm < 2; ++mm) {
        const int m = mp * 2 + mm;
        const int row = row0 + ai * 128 + m * 16;
        float4 cs[4];
        cs[0] = csb[mm][0]; cs[1] = csb[mm][1]; cs[2] = csb[mm][2]; cs[3] = csb[mm][3];
        u16* prow = P + (size_t)row * 6656 + col0;
#pragma unroll
        for (int bj = 0; bj < 2; ++bj) {
          pg8::f32x4 v0 = acc[ai][bj][m][0], v1 = acc[ai][bj][m][1];
          if (rope) {
            float mine[8] = {v0[0], v0[1], v0[2], v0[3], v1[0], v1[1], v1[2], v1[3]};
            float cc[8] = {cs[0].x, cs[0].z, cs[1].x, cs[1].z, cs[2].x, cs[2].z, cs[3].x, cs[3].z};
            float sn[8] = {cs[0].y, cs[0].w, cs[1].y, cs[1].w, cs[2].y, cs[2].w, cs[3].y, cs[3].w};
            float res[8];
#pragma unroll
            for (int e = 0; e < 8; ++e) {
              const float other = __shfl_xor(mine[e], 32);
              res[e] = hi ? (mine[e] * cc[e] + other * sn[e]) : (mine[e] * cc[e] - other * sn[e]);
            }
            v0 = (pg8::f32x4){res[0], res[1], res[2], res[3]};
            v1 = (pg8::f32x4){res[4], res[5], res[6], res[7]};
          }
          pg8::u32x4 w;
          w.x = pg8::cvt_pk_bf16(v0[0], v0[1]); w.y = pg8::cvt_pk_bf16(v0[2], v0[3]);
          w.z = pg8::cvt_pk_bf16(v1[0], v1[1]); w.w = pg8::cvt_pk_bf16(v1[2], v1[3]);
          *(pg8::u32x4*)(prow + bj * 128) = w;
          if (kvout) {
            const int bb = row >> 8, t = row & 255;
            float* o = out + (piece == 6 ? OUT_K : OUT_V) + ((size_t)((bb * 2 + l) * 256 + t)) * 512 + (col0 + bj * 128 - piece * 512);
            *(pg8::f32x4*)o = v0;
            *(pg8::f32x4*)(o + 4) = v1;
          }
        }
      }
      }
  }
};
struct EpiG2 {
  static constexpr bool PERM = false, AFTER_DRAIN = false;
  u16* PRE; const float* MOD; const float* xp; const float* xs; const float* xo; const float* bo; int l;
  __device__ __forceinline__ void operator()(const pg8::f32x4 (&acc)[2][2][4][2], const pg8::Unit& u, int wr, int wc, int fr, int fq) const {
    const float alpha = 1.41421356237f;
    const int row0 = u.pm * 256 + wr * 64 + fr, col0 = u.pn * 256 + wc * 32 + 4 * fq;
    const int r = u.pm < 16 ? 0 : 1 + ((u.pm - 16) >> 2);
    const float* gate = MOD + (l * 5 + r) * 6144 + 4096 + col0;
    const float* xbase = (l == 0) ? ((u.pm < 16) ? xp : xs - (size_t)4096 * 2048) : xo;
    pg8::f32x4 bv[2][2], gv[2][2];
#pragma unroll
    for (int bj = 0; bj < 2; ++bj)
#pragma unroll
      for (int n = 0; n < 2; ++n) {
        bv[bj][n] = *(const pg8::f32x4*)(bo + l * 2048 + col0 + bj * 128 + n * 16);
        gv[bj][n] = *(const pg8::f32x4*)(gate + bj * 128 + n * 16);
      }
#pragma unroll
    for (int ai = 0; ai < 2; ++ai)
#pragma unroll
      for (int mp = 0; mp < 2; ++mp) {
        pg8::f32x4 x4[2][2][2];
#pragma unroll
        for (int mm = 0; mm < 2; ++mm)
#pragma unroll
          for (int bj = 0; bj < 2; ++bj)
#pragma unroll
            for (int n = 0; n < 2; ++n)
              x4[mm][bj][n] = *(const pg8::f32x4*)(xbase + (size_t)(row0 + ai * 128 + (mp * 2 + mm) * 16) * 2048 + col0 + bj * 128 + n * 16);
#pragma unroll
        for (int mm = 0; mm < 2; ++mm) {
          const int m = mp * 2 + mm;
          u16* dst = PRE + (size_t)(row0 + ai * 128 + m * 16) * 2048 + col0;
#pragma unroll
          for (int bj = 0; bj < 2; ++bj)
#pragma unroll
            for (int n = 0; n < 2; ++n) {
              const pg8::f32x4 r4 = alpha * x4[mm][bj][n] + gv[bj][n] * (acc[ai][bj][m][n] + bv[bj][n]);
              uint2 w;
              w.x = pg8::cvt_pk_bf16(r4[0], r4[1]); w.y = pg8::cvt_pk_bf16(r4[2], r4[3]);
              *(uint2*)(dst + bj * 128 + n * 16) = w;
            }
        }
      }
  }
};

template <int MODE>
DEV void phase_gemm(const Params& p, int l, int bid, int nb, char* smem) {
  pg8::Gemm g;
  pg8::StaticOrder S;
  PG8_LAS unsigned char* lds = (PG8_LAS unsigned char*)smem;
  if (MODE == 1) {
    g.A = (const u16*)(p.ws + OFF_H); g.Bt = (const u16*)(p.ws + OFF_WINT) + (size_t)l * 6656 * 2048; g.M = 8192; g.N = 6144; g.K = 2048;
    S.init(8192, 6144, nb, bid);
    EpiG1 E; E.P = (u16*)(p.ws + OFF_P); E.out = p.out; E.ROPE = (const float2*)(p.ws + OFF_ROPE); E.l = l; E.colbase = 0;
    pg8::gemm_phase<EpiG1, pg8::StaticOrder, false>(lds, g, S, E, nullptr);
  } else {
    g.A = (const u16*)(p.ws + OFF_Y); g.Bt = (const u16*)(p.ws + OFF_WOUTT) + (size_t)l * 2048 * 2048; g.M = 8192; g.N = 2048; g.K = 2048;
    S.init(8192, 2048, nb, bid);
    EpiG2 E; E.PRE = (u16*)(p.ws + OFF_P); E.MOD = (const float*)(p.ws + OFF_MOD); E.xp = p.x_prompt; E.xs = p.x_sample; E.xo = p.out; E.bo = p.b_out; E.l = l;
    pg8::gemm_phase<EpiG2, pg8::StaticOrder, false>(lds, g, S, E, nullptr);
  }
}

struct OneUnit {
  int pm, pn;
  __device__ bool next(int i, pg8::Unit& u) const { if (i) return false; u.pm = pm; u.pn = pn; return true; }
  __device__ __forceinline__ void a_ready(const pg8::Unit&) const {}
  __device__ __forceinline__ void done(const pg8::Unit&) const {}
};
constexpr int FLG_WORD0 = 256;
DEV void gemm1_tail_unit(const Params& p, int l, int ti) {
  const int pm = ti & 31, pn = ti >> 5;
  pg8::Gemm g;
  g.A = (const u16*)(p.ws + OFF_H); g.Bt = (const u16*)(p.ws + OFF_WINT) + (size_t)l * 6656 * 2048 + (size_t)6144 * 2048; g.M = 8192; g.N = 512; g.K = 2048;
  OneUnit S; S.pm = pm; S.pn = pn;
  EpiG1 E; E.P = (u16*)(p.ws + OFF_P); E.out = p.out; E.ROPE = (const float2*)(p.ws + OFF_ROPE); E.l = l; E.colbase = 6144;
  pg8::gemm_phase<EpiG1, OneUnit, false>((PG8_LAS unsigned char*)dyn_smem, g, S, E, nullptr);
  if (threadIdx.x == 0) {
    __builtin_amdgcn_fence(__ATOMIC_RELEASE, "agent");
    asm volatile("s_waitcnt vmcnt(0)" ::: "memory");
    __hip_atomic_store((unsigned*)(p.ws + OFF_CNT) + FLG_WORD0 + l * 64 + pm * 2 + pn, 1u, __ATOMIC_RELAXED, __HIP_MEMORY_SCOPE_AGENT);
  }
}
DEV void wait_tail_flags(const Params& p, int l, int pm0, int npm, int pn) {
  unsigned* f = (unsigned*)(p.ws + OFF_CNT) + FLG_WORD0 + l * 64 + pn;
  for (int k = 0; k < npm; k++) {
    unsigned sp = 0;
    while (__hip_atomic_load(f + (pm0 + k) * 2, __ATOMIC_RELAXED, __HIP_MEMORY_SCOPE_AGENT) == 0u) {
      __builtin_amdgcn_s_sleep(2);
      if (++sp > (1u << 22)) break;
    }
  }
  __builtin_amdgcn_fence(__ATOMIC_ACQUIRE, "agent");
  asm volatile("s_waitcnt vmcnt(0)" ::: "memory");
}

DEV void mm128(const char* Al, const char* Bl, f32x4 (&acc)[2][8], int wave, int lane) {
  const int l15 = lane & 15, quad = lane >> 4, q4 = l15 >> 2, p4 = lane & 3;
  const unsigned bbase = (unsigned)(size_t)Bl + (quad * 8 + q4) * 288 + p4 * 8;
#pragma unroll
  for (int ks = 0; ks < 4; ks++) {
    bf16x8 a[2];
#pragma unroll
    for (int mt = 0; mt < 2; mt++) a[mt] = *(const bf16x8*)(Al + (wave * 32 + mt * 16 + l15) * 272 + ks * 64 + quad * 16);
#pragma unroll
    for (int nb4 = 0; nb4 < 2; nb4++) {
      bf16x8 b[4];
      tr_read2x4(bbase + ks * 32 * 288 + nb4 * 128, bbase + ks * 32 * 288 + 4 * 288 + nb4 * 128, 32, b);
#pragma unroll
      for (int q = 0; q < 4; q++)
#pragma unroll
        for (int mt = 0; mt < 2; mt++) acc[mt][nb4 * 4 + q] = mfma16(a[mt], b[q], acc[mt][nb4 * 4 + q]);
    }
  }
}

DEV void load_f32_tile_bf16(const float* src, char* dst, int stride_bytes) {
  const int tid = launder_tid();
#pragma unroll
  for (int i = 0; i < 8; i++) {
    int idx = tid + 256 * i, r = idx >> 4, c8 = idx & 15;
    float4 a = *(const float4*)(src + r * 128 + c8 * 8), b = *(const float4*)(src + r * 128 + c8 * 8 + 4);
    float f[8] = {a.x, a.y, a.z, a.w, b.x, b.y, b.z, b.w};
    *(bf16x8*)(dst + r * stride_bytes + c8 * 16) = pack8(f);
  }
}

DEV void gmlp_item(const Params& p, int l, int chunk, int g, char* smem) {
  char* Al = smem;
  char* Bl = smem + 34816;
  const int tid = launder_tid(), lane = tid & 63, wave = tid >> 6, l15 = lane & 15, quad = lane >> 4;
  const u16* P = (const u16*)(p.ws + OFF_P);
  u16* Y = (u16*)(p.ws + OFF_Y);
  const int r0 = chunk * 128;
  load_f32_tile_bf16(p.gmlp_w + (size_t)(l * 4 + g) * 16384, Al, 272);
#pragma unroll 1
  for (int rb = 0; rb < 4; rb++) {
    bf16x8 vv[8];
#pragma unroll
    for (int k = 0; k < 8; k++) vv[k] = *(const bf16x8*)(P + (size_t)(r0 + wave * 32 + rb * 8 + k) * 6656 + 512 + lane * 8);
#pragma unroll
    for (int k = 0; k < 8; k++) {
      const int j = wave * 32 + rb * 8 + k;
      float f[8];
      float sm1 = 0.f;
#pragma unroll
      for (int e = 0; e < 8; e++) { f[e] = bf2f(vv[k][e]); sm1 += f[e]; }
      const float mean = wave_sum(sm1) * (1.f / 512.f);
      float q = 0.f;
#pragma unroll
      for (int e = 0; e < 8; e++) { f[e] -= mean; q += f[e] * f[e]; }
      const float rstd = rsqrtf(wave_sum(q) * (1.f / 512.f) + 1e-6f);
      if (quad == g) {
#pragma unroll
        for (int e = 0; e < 8; e++) f[e] *= rstd;
        *(bf16x8*)(Bl + j * 288 + l15 * 16) = pack8(f);
      }
    }
  }
  __syncthreads();
  f32x4 acc[2][8];
#pragma unroll
  for (int i = 0; i < 2; i++)
#pragma unroll
    for (int j = 0; j < 8; j++) acc[i][j] = (f32x4){0.f, 0.f, 0.f, 0.f};
  mm128(Al, Bl, acc, wave, lane);
  __syncthreads();
  float* Ct = (float*)smem + wave * 32 * 132;
#pragma unroll
  for (int mt = 0; mt < 2; mt++)
#pragma unroll
    for (int nt = 0; nt < 8; nt++)
#pragma unroll
      for (int j = 0; j < 4; j++) Ct[(mt * 16 + quad * 4 + j) * 132 + nt * 16 + l15] = acc[mt][nt][j];
#pragma unroll 2
  for (int k = 0; k < 8; k++) {
    const int id = lane + 64 * k, r = id >> 4, c8 = (id & 15) * 8;
    const int i = wave * 32 + r;
    const float bs = p.gmlp_b[(l * 4 + g) * 128 + i];
    const u16* pr = P + (size_t)(r0 + i) * 6656 + g * 128 + c8;
    bf16x8 uv = *(const bf16x8*)pr;
    bf16x8 gv = *(const bf16x8*)(pr + 1024);
    float4 a0 = *(const float4*)(Ct + r * 132 + c8), a1 = *(const float4*)(Ct + r * 132 + c8 + 4);
    float av[8] = {a0.x, a0.y, a0.z, a0.w, a1.x, a1.y, a1.z, a1.w};
    float f[8];
#pragma unroll
    for (int e = 0; e < 8; e++) f[e] = silu(bf2f(gv[e])) * bf2f(uv[e]) * (av[e] + bs);
    *(bf16x8*)(Y + (size_t)(r0 + i) * 2048 + g * 128 + c8) = pack8(f);
  }
  __syncthreads();
}

DEV void pool_item(const Params& p, int l, int tile, int g, char* smem) {
  char* Sl = smem;
  char* Al = smem + 36864;
  const int tid = launder_tid(), lane = tid & 63, wave = tid >> 6, l15 = lane & 15, quad = lane >> 4;
  const u16* P = (const u16*)(p.ws + OFF_P);
  u16* Y = (u16*)(p.ws + OFF_Y);
  const int r0 = tile * 128;
  int s0, L;
  if (r0 < 4096) { s0 = r0 & ~255; L = 256; } else { s0 = 4096 + ((r0 - 4096) & ~1023); L = 1024; }
  const int w2 = 1 << g;
  for (int idx = tid; idx < 144 * 16; idx += 256) {
    int rr = idx >> 4, c8 = idx & 15;
    int row = r0 - 8 + rr;
    bf16x8 v = (bf16x8){0, 0, 0, 0, 0, 0, 0, 0};
    if (row >= s0 && row < s0 + L) v = *(const bf16x8*)(P + (size_t)row * 6656 + 3 * 512 + g * 128 + c8 * 8);
    *(bf16x8*)(Sl + rr * 256 + c8 * 16) = v;
  }
  __syncthreads();
#pragma unroll 1
  for (int i = 0; i < 8; i++) {
    int idx = tid + 256 * i, t = idx >> 4, c8 = idx & 15;
    int tl = r0 + t - s0;
    int lo = max(tl - w2, 0), hi = min(tl + w2, L);
    float s[8];
#pragma unroll
    for (int e = 0; e < 8; e++) s[e] = 0.f;
    for (int u = lo; u < hi; u++) {
      bf16x8 v = *(const bf16x8*)(Sl + (u - tl + t + 8) * 256 + c8 * 16);
#pragma unroll
      for (int e = 0; e < 8; e++) s[e] += bf2f(v[e]);
    }
    const float inv = 1.f / (float)(hi - lo);
    bf16x8 cv = *(const bf16x8*)(Sl + (t + 8) * 256 + c8 * 16);
#pragma unroll
    for (int e = 0; e < 8; e++) s[e] = s[e] * inv - bf2f(cv[e]);
    *(bf16x8*)(Al + t * 272 + c8 * 16) = pack8(s);
  }
  __syncthreads();
  load_f32_tile_bf16(p.pool_w + (size_t)(l * 4 + g) * 16384, Sl, 288);
  __syncthreads();
  f32x4 acc[2][8];
#pragma unroll
  for (int i = 0; i < 2; i++)
#pragma unroll
    for (int j = 0; j < 8; j++) acc[i][j] = (f32x4){0.f, 0.f, 0.f, 0.f};
  mm128(Al, Sl, acc, wave, lane);
  __syncthreads();
  float* Ct = (float*)smem + wave * 32 * 132;
#pragma unroll
  for (int mt = 0; mt < 2; mt++)
#pragma unroll
    for (int nt = 0; nt < 8; nt++)
#pragma unroll
      for (int j = 0; j < 4; j++) Ct[(mt * 16 + quad * 4 + j) * 132 + nt * 16 + l15] = acc[mt][nt][j];
#pragma unroll 2
  for (int k = 0; k < 8; k++) {
    const int id = lane + 64 * k, r = id >> 4, c8 = (id & 15) * 8;
    const int row = r0 + wave * 32 + r;
    bf16x8 gv = *(const bf16x8*)(P + (size_t)row * 6656 + 4 * 512 + g * 128 + c8);
    const float* psc = p.pool_scale + l * 512 + g * 128 + c8;
    float4 s0 = *(const float4*)psc, s1 = *(const float4*)(psc + 4);
    float sv[8] = {s0.x, s0.y, s0.z, s0.w, s1.x, s1.y, s1.z, s1.w};
    float4 a0 = *(const float4*)(Ct + r * 132 + c8), a1 = *(const float4*)(Ct + r * 132 + c8 + 4);
    float av[8] = {a0.x, a0.y, a0.z, a0.w, a1.x, a1.y, a1.z, a1.w};
    float f[8];
#pragma unroll
    for (int e = 0; e < 8; e++) f[e] = av[e] * sv[e] * silu(bf2f(gv[e]));
    *(bf16x8*)(Y + (size_t)row * 2048 + 512 + g * 128 + c8) = pack8(f);
  }
  __syncthreads();
}

DEV void attn_item(const Params& p, int l, int path, int b, int h, int qb, char* smem) {
  char* Kl = smem;
  char* Vl = smem + 17408;
  float* Ol = (float*)smem;
  const int tid = launder_tid(), lane = tid & 63, wave = tid >> 6, l15 = lane & 15, quad = lane >> 4;
  const int q4 = l15 >> 2, p4 = lane & 3;
  const u16* P = (const u16*)(p.ws + OFF_P);
  u16* Y = (u16*)(p.ws + OFF_Y);
  const int rowbase = path ? 4096 + b * 1024 : b * 256;
  const int nkeys = path ? 1536 : 256;
  const int ncache = path ? 512 : 0;
  const float* lq = p.lambda_qk + l * 256;
  const float d01 = wave_sum(lq[lane] * lq[64 + lane]);
  const float d23 = wave_sum(lq[128 + lane] * lq[192 + lane]);
  const float lam_init = 0.8f - 0.6f * expf(-0.3f * (float)l);
  const float lam = expf(d01) - expf(d23) + lam_init;
  bf16x8 qf[2][2];
  {
    const int qrow = rowbase + qb * 64 + wave * 16 + l15;
#pragma unroll
    for (int m = 0; m < 2; m++)
#pragma unroll
      for (int ks = 0; ks < 2; ks++) {
        bf16x8 v = *(const bf16x8*)(P + (size_t)qrow * 6656 + 5 * 512 + h * 128 + m * 64 + ks * 32 + quad * 8);
#pragma unroll
        for (int e = 0; e < 8; e++) v[e] = (short)f2bf(bf2f(v[e]) * 0.125f);
        qf[m][ks] = v;
      }
  }
  f32x4 o[2][8];
#pragma unroll
  for (int m = 0; m < 2; m++)
#pragma unroll
    for (int dt = 0; dt < 8; dt++) o[m][dt] = (f32x4){0.f, 0.f, 0.f, 0.f};
  float mrun[2] = {-1e30f, -1e30f}, lrun[2] = {0.f, 0.f};
  const unsigned vbase = (unsigned)(size_t)Vl + (quad * 4 + q4) * 288 + p4 * 8;
  const u16* KC = (const u16*)(p.ws + OFF_KC);
  const u16* VC = (const u16*)(p.ws + OFF_VC);
  const int ntile = nkeys >> 6;
  bf16x8 rk[4], rv[4];
  auto gload = [&](int t) {
    const int kt0 = t * 64;
#pragma unroll
    for (int i = 0; i < 4; i++) {
      const int chunk = tid + 256 * i, key = chunk >> 4, dc = chunk & 15;
      const int kg = kt0 + key;
      if (kt0 < ncache) {
        const size_t off = (((size_t)b * 2 + l) * 512 + kg) * 512 + h * 128 + dc * 8;
        rk[i] = *(const bf16x8*)(KC + off);
        rv[i] = *(const bf16x8*)(VC + off);
      } else {
        const size_t row = rowbase + (kg - ncache);
        rk[i] = *(const bf16x8*)(P + row * 6656 + 6 * 512 + h * 128 + dc * 8);
        rv[i] = *(const bf16x8*)(P + row * 6656 + 7 * 512 + h * 128 + dc * 8);
      }
    }
  };
  auto lstore = [&](int st) {
#pragma unroll
    for (int i = 0; i < 4; i++) {
      const int chunk = tid + 256 * i, key = chunk >> 4, dc = chunk & 15;
      *(bf16x8*)(Kl + st * 35840 + key * 272 + dc * 16) = rk[i];
      *(bf16x8*)(Vl + st * 35840 + key * 288 + dc * 16) = rv[i];
    }
  };
  __syncthreads();
  gload(0);
  lstore(0);
  if (ntile > 1) gload(1);
  __syncthreads();
#pragma unroll 1
  for (int t = 0; t < ntile; t++) {
    const int stg = t & 1;
    const char* Kc = Kl + stg * 35840;
    const unsigned vb = vbase + stg * 35840;
    if (t + 1 < ntile) {
      lstore(stg ^ 1);
      if (t + 2 < ntile) gload(t + 2);
    }
    __builtin_amdgcn_sched_barrier(0);
    f32x4 s[2][4];
#pragma unroll
    for (int m = 0; m < 2; m++)
#pragma unroll
      for (int kt = 0; kt < 4; kt++) {
        f32x4 a4 = (f32x4){0.f, 0.f, 0.f, 0.f};
#pragma unroll
        for (int ks = 0; ks < 2; ks++) {
          bf16x8 a = *(const bf16x8*)(Kc + (kt * 16 + l15) * 272 + m * 128 + ks * 64 + quad * 16);
          a4 = mfma16(a, qf[m][ks], a4);
        }
        s[m][kt] = a4;
        if (kt & 1) __builtin_amdgcn_sched_barrier(0);
      }
    bf16x8 pf[2][2];
#pragma unroll
    for (int m = 0; m < 2; m++) {
      float tmax = -1e30f;
#pragma unroll
      for (int kt = 0; kt < 4; kt++)
#pragma unroll
        for (int j = 0; j < 4; j++) tmax = fmaxf(tmax, s[m][kt][j]);
      tmax = fmaxf(tmax, __shfl_xor(tmax, 16));
      tmax = fmaxf(tmax, __shfl_xor(tmax, 32));
      const float mnew = fmaxf(mrun[m], tmax);
      const float alpha = __expf(mrun[m] - mnew);
      mrun[m] = mnew;
      float psum = 0.f;
#pragma unroll
      for (int kt = 0; kt < 4; kt++)
#pragma unroll
        for (int j = 0; j < 4; j++) {
          float pv = __expf(s[m][kt][j] - mnew);
          psum += pv;
          s[m][kt][j] = pv;
        }
      lrun[m] = lrun[m] * alpha + psum;
#pragma unroll
      for (int dt = 0; dt < 8; dt++) {
        o[m][dt][0] *= alpha; o[m][dt][1] *= alpha; o[m][dt][2] *= alpha; o[m][dt][3] *= alpha;
      }
#pragma unroll
      for (int kk = 0; kk < 2; kk++) {
        bf16x8 t;
#pragma unroll
        for (int j = 0; j < 4; j++) {
          t[j] = (short)f2bf(s[m][2 * kk][j]);
          t[4 + j] = (short)f2bf(s[m][2 * kk + 1][j]);
        }
        pf[m][kk] = t;
      }
    }
#pragma unroll
    for (int kk = 0; kk < 2; kk++)
#pragma unroll
      for (int d4 = 0; d4 < 2; d4++) {
        bf16x8 a[4];
        tr_read2x4(vb + (2 * kk) * 16 * 288 + d4 * 128, vb + (2 * kk + 1) * 16 * 288 + d4 * 128, 32, a);
#pragma unroll
        for (int q = 0; q < 4; q++) {
          o[0][d4 * 4 + q] = mfma16(a[q], pf[0][kk], o[0][d4 * 4 + q]);
          o[1][d4 * 4 + q] = mfma16(a[q], pf[1][kk], o[1][d4 * 4 + q]);
        }
        __builtin_amdgcn_sched_barrier(0);
      }
    __syncthreads();
  }
  float l0 = lrun[0], l1 = lrun[1];
  l0 += __shfl_xor(l0, 16); l0 += __shfl_xor(l0, 32);
  l1 += __shfl_xor(l1, 16); l1 += __shfl_xor(l1, 32);
  const float i0 = 1.f / l0, i1 = lam / l1;
  float ss = 0.f;
#pragma unroll
  for (int dt = 0; dt < 8; dt++)
#pragma unroll
    for (int j = 0; j < 4; j++) {
      float v = o[0][dt][j] * i0 - o[1][dt][j] * i1;
      o[0][dt][j] = v;
      ss += v * v;
    }
  ss += __shfl_xor(ss, 16);
  ss += __shfl_xor(ss, 32);
  const float sc = rsqrtf(ss * (1.f / 128.f) + 1e-5f) * (1.f - lam_init);
  __syncthreads();
#pragma unroll
  for (int dt = 0; dt < 8; dt++)
#pragma unroll
    for (int j = 0; j < 4; j++) Ol[(wave * 16 + l15) * 132 + dt * 16 + quad * 4 + j] = o[0][dt][j] * sc;
  __syncthreads();
#pragma unroll
  for (int i = 0; i < 4; i++) {
    const int idx = tid + 256 * i, qr = idx >> 4, dc = idx & 15;
    const size_t row = rowbase + qb * 64 + qr;
    bf16x8 gv = *(const bf16x8*)(P + row * 6656 + 8 * 512 + h * 128 + dc * 8);
    float f[8];
#pragma unroll
    for (int e = 0; e < 8; e++) f[e] = Ol[qr * 132 + dc * 8 + e] * p.subln_w[l * 128 + dc * 8 + e] * silu(bf2f(gv[e]));
    *(bf16x8*)(Y + row * 2048 + 1024 + h * 128 + dc * 8) = pack8(f);
  }
  __syncthreads();
}

template <int L, int CG>
DEV void hyena_item(const Params& p, int l, int path, int b, int cgi, char* smem) {
  constexpr int ZLEN = L + 512;
  constexpr int XLEN = 2 * L + 16;
  constexpr int FBL = 2 * L + 32;
  constexpr int NG = L / 256;
  constexpr int NCH = CG / 8;
  u16* zb = (u16*)smem;
  u16* g1b = zb + CG * ZLEN;
  u16* fball = g1b + CG * L;
  const int tid = launder_tid(), lane = tid & 63, wave = tid >> 6, l15 = lane & 15, quad = lane >> 4;
  const u16* P = (const u16*)(p.ws + OFF_P);
  u16* Y = (u16*)(p.ws + OFF_Y);
  const int rowbase = path ? 4096 + b * 1024 : b * 256;
  const int c0 = cgi * CG;
  const float* cw = p.conv_w + l * 3 * 1536;
  const float* cb = p.conv_b + l * 1536;
  __syncthreads();
  for (int i = tid; i < CG * 512; i += 256) {
    int c = i >> 9, x = i & 511;
    zb[c * ZLEN + (x < 256 ? x : L + x)] = 0;
  }
  if (lane < 16) fball[wave * FBL + lane] = 0;
  constexpr int NREG = (XLEN / 8 + 63) / 64;
  constexpr int NQ = (CG / 4) * 2;
  const u16* Fg = (const u16*)(p.ws + (path ? OFF_F1 : OFF_F0));
  const float* FN = (const float*)(p.ws + OFF_FN);
  bf16x8 frA[NREG], frB[NREG];
  float nrmA = 0.f, biasA = 0.f, nrmB = 0.f, biasB = 0.f;
  auto fetch_filter = [&](int q, bf16x8 (&fr)[NREG], float& nrm_pf, float& bias_pf) {
    const int chq = c0 + wave + 4 * (q >> 1), oq = q & 1;
    const u16* R = Fg + ((size_t)((l * 2 + oq) * 512 + chq)) * XLEN;
#pragma unroll
    for (int k = 0; k < NREG; k++) {
      const int i = lane + 64 * k;
      if (i < XLEN / 8) fr[k] = *(const bf16x8*)(R + i * 8);
    }
    nrm_pf = 0.f;
    if (lane < 2 * (L / 32)) nrm_pf = FN[((((path * 2 + l) * 4 + oq * 2 + (lane & 1)) * 32) + (lane >> 1)) * 512 + chq];
    bias_pf = p.hyena_bias[(l * 2 + oq) * 512 + chq];
  };
  fetch_filter(0, frA, nrmA, biasA);
  const bf16x8 zero8 = (bf16x8){0, 0, 0, 0, 0, 0, 0, 0};
#pragma unroll
  for (int cc = 0; cc < NCH; cc++) {
    const int ch = c0 + cc * 8;
#pragma unroll
    for (int it = 0; it < L / 256; it++) {
      const int t = tid + it * 256;
      bf16x8 xv[3], hv[3];
#pragma unroll
      for (int dtp = 0; dtp < 3; dtp++) {
        const int tt = t + dtp - 1;
        const int ttc = min(max(tt, 0), L - 1);
        const u16* pr = P + (size_t)(rowbase + ttc) * 6656;
        xv[dtp] = *(const bf16x8*)(pr + 9 * 512 + ch);
        hv[dtp] = *(const bf16x8*)(pr + 11 * 512 + ch);
        if (tt != ttc) { xv[dtp] = zero8; hv[dtp] = zero8; }
      }
      float z[8], g1[8];
#pragma unroll
      for (int e = 0; e < 8; e++) { z[e] = cb[1024 + ch + e]; g1[e] = cb[ch + e]; }
#pragma unroll
      for (int dtp = 0; dtp < 3; dtp++)
#pragma unroll
        for (int e = 0; e < 8; e++) {
          g1[e] += bf2f(xv[dtp][e]) * cw[dtp * 1536 + ch + e];
          z[e] += bf2f(hv[dtp][e]) * cw[dtp * 1536 + 1024 + ch + e];
        }
#pragma unroll
      for (int e = 0; e < 8; e++) {
        zb[(cc * 8 + e) * ZLEN + 256 + t] = f2bf(z[e]);
        g1b[(cc * 8 + e) * L + t] = f2bf(g1[e]);
      }
    }
  }
  __syncthreads();
  u16* fb = fball + wave * FBL;
  auto conv_step = [&](int q, bf16x8 (&fr)[NREG], float nrm_pf, float bias_pf, bf16x8 (&frn)[NREG], float& nrmn, float& biasn) {
    const int cl = wave + 4 * (q >> 1);
    const int o = q & 1;
    u16* zc = zb + cl * ZLEN;
    {
#pragma unroll
      for (int k = 0; k < NREG; k++) {
        const int i = lane + 64 * k;
        if (i < XLEN / 8) *(bf16x8*)(fb + 16 + i * 8) = fr[k];
      }
      const float invn = 1.f / wave_sum(nrm_pf);
      const float bias = bias_pf;
      if (q + 1 < NQ) fetch_filter(q + 1, frn, nrmn, biasn);
      f32x4 acc[NG];
#pragma unroll
      for (int ng = 0; ng < NG; ng++) acc[ng] = (f32x4){0.f, 0.f, 0.f, 0.f};
      const int ebase = L - l15 + quad * 8 + 16;
#pragma unroll 2
      for (int u = -256; u <= L - 32; u += 32) {
        const bf16x8 bz = *(const bf16x8*)(zc + 256 + u + l15 * 16 + quad * 8);
#pragma unroll
        for (int ng = 0; ng < NG; ng++) {
          const int e0 = ebase - ng * 256 + u;
          const unsigned* fw = (const unsigned*)fb + (e0 >> 1);
          const unsigned sh = (e0 & 1) * 2;
          unsigned d0 = fw[0], d1 = fw[1], d2 = fw[2], d3 = fw[3], d4 = fw[4];
          union { unsigned u4[4]; bf16x8 v; } af;
          af.u4[0] = __builtin_amdgcn_alignbyte(d1, d0, sh);
          af.u4[1] = __builtin_amdgcn_alignbyte(d2, d1, sh);
          af.u4[2] = __builtin_amdgcn_alignbyte(d3, d2, sh);
          af.u4[3] = __builtin_amdgcn_alignbyte(d4, d3, sh);
          acc[ng] = mfma16(af.v, bz, acc[ng]);
        }
      }
#pragma unroll
      for (int ng = 0; ng < NG; ng++) {
        const int t = ng * 256 + l15 * 16 + quad * 4;
        bf16x4 zv = *(const bf16x4*)(zc + 256 + t);
        bf16x4 ov;
        if (o == 0) {
          bf16x4 gv = *(const bf16x4*)(g1b + cl * L + t);
#pragma unroll
          for (int j = 0; j < 4; j++) ov[j] = (short)f2bf(bf2f(gv[j]) * (acc[ng][j] * invn + bf2f(zv[j]) * bias));
        } else {
#pragma unroll
          for (int j = 0; j < 4; j++) ov[j] = (short)f2bf(acc[ng][j] * invn + bf2f(zv[j]) * bias);
        }
        *(bf16x4*)(zc + 256 + t) = ov;
      }
    }
  };
#pragma unroll 1
  for (int q = 0; q < NQ; q += 2) {
    conv_step(q, frA, nrmA, biasA, frB, nrmB, biasB);
    conv_step(q + 1, frB, nrmB, biasB, frA, nrmA, biasA);
  }
  if (tid == 0) {
    if (path) wait_tail_flags(p, l, 16 + 4 * b, 4, c0 >> 8);
    else wait_tail_flags(p, l, b, 1, c0 >> 8);
  }
  __syncthreads();
#pragma unroll
  for (int cc = 0; cc < NCH; cc++) {
    const int ch = c0 + cc * 8;
#pragma unroll
    for (int it = 0; it < L / 256; it++) {
      const int t = tid + it * 256;
      bf16x8 xv[3];
#pragma unroll
      for (int dtp = 0; dtp < 3; dtp++) {
        const int tt = t + dtp - 1;
        const int ttc = min(max(tt, 0), L - 1);
        xv[dtp] = *(const bf16x8*)(P + (size_t)(rowbase + ttc) * 6656 + 10 * 512 + ch);
        if (tt != ttc) xv[dtp] = zero8;
      }
      const bf16x8 dg = *(const bf16x8*)(P + (size_t)(rowbase + t) * 6656 + 12 * 512 + ch);
      float g2[8];
#pragma unroll
      for (int e = 0; e < 8; e++) g2[e] = cb[512 + ch + e];
#pragma unroll
      for (int dtp = 0; dtp < 3; dtp++)
#pragma unroll
        for (int e = 0; e < 8; e++) g2[e] += bf2f(xv[dtp][e]) * cw[dtp * 1536 + 512 + ch + e];
      float f[8];
#pragma unroll
      for (int e = 0; e < 8; e++) f[e] = bf2f((short)zb[(cc * 8 + e) * ZLEN + 256 + t]) * g2[e] * silu(bf2f(dg[e]));
      *(bf16x8*)(Y + (size_t)(rowbase + t) * 2048 + 1536 + ch) = pack8(f);
    }
  }
  __syncthreads();
}

#ifndef R_HY
#define R_HY 1
#endif
#ifndef R_AT
#define R_AT 1
#endif
#ifndef R_GP
#define R_GP 1
#endif
DEV void phase_mix(const Params& p, int l, int bid, int nb, char* smem) {
  constexpr int N_HL = 256, N_AL = 256, N_HC = 512, N_AC = 256, N_G = 256, N_PL = 256;
  constexpr int TOT0 = N_HL + N_AL + N_HC + N_AC + N_G + N_PL;
  const int TOT = TOT0 + (l == 0 ? 1088 : 0);
  const int team = __builtin_amdgcn_readfirstlane(threadIdx.x >> 8);
  smem += team * LDS_TEAM;
  volatile LAS unsigned* stq = (volatile LAS unsigned*)(dyn_smem + LDS_MAIN);
  unsigned* cnt = (unsigned*)(p.ws + OFF_CNT) + 16 * (1 + l);
  for (;;) {
    __syncthreads();
    if (threadIdx.x == 0) stq[2] = atomicAdd(cnt, 1u);
    __syncthreads();
    int jp = (int)stq[2];
    if (jp >= 64 + TOT / 2) break;
    if (jp < 64) { gemm1_tail_unit(p, l, jp); continue; }
    jp -= 64;
    int i = jp * 2 + team;
    if (i < N_HL) { for (int r = 0; r < R_HY; r++) hyena_item<1024, 8>(p, l, 1, i >> 6, i & 63, smem); continue; }
    i -= N_HL;
    if (i < N_AL) { for (int r = 0; r < R_AT; r++) attn_item(p, l, 1, i >> 6, (i >> 4) & 3, i & 15, smem); continue; }
    i -= N_AL;
    if (i < N_HC) { for (int r = 0; r < R_HY; r++) hyena_item<256, 16>(p, l, 0, i >> 5, i & 31, smem); continue; }
    i -= N_HC;
    if (i < N_AC) { for (int r = 0; r < R_AT; r++) attn_item(p, l, 0, i >> 4, (i >> 2) & 3, i & 3, smem); continue; }
    i -= N_AC;
    if (i < N_G) { for (int r = 0; r < R_GP; r++) gmlp_item(p, l, i >> 2, i & 3, smem); continue; }
    i -= N_G;
    if (i < N_PL) { for (int r = 0; r < R_GP; r++) pool_item(p, l, i >> 2, i & 3, smem); continue; }
    i -= N_PL;
    if (i < 832) {
      p0_transpose(p.w_in + (size_t)2048 * 6656, (u16*)(p.ws + OFF_WINT) + (size_t)6656 * 2048, 2048, 6656, i / 26, i % 26, smem);
    } else {
      i -= 832;
      p0_transpose(p.w_out + (size_t)2048 * 2048, (u16*)(p.ws + OFF_WOUTT) + (size_t)2048 * 2048, 2048, 2048, i / 8, i % 8, smem);
    }
  }
}


#ifndef REP_PREP
#define REP_PREP 1
#endif
#ifndef REP_ROWS
#define REP_ROWS 1
#endif
#ifndef REP_G1
#define REP_G1 1
#endif
#ifndef REP_MIX
#define REP_MIX 1
#endif
#ifndef REP_G2
#define REP_G2 1
#endif
__global__ void __launch_bounds__(512, 2) mega_kernel(Params p) {
  cg::grid_group grid = cg::this_grid();
  const int bid = blockIdx.x, nb = gridDim.x;
  volatile LAS unsigned* st = (volatile LAS unsigned*)(dyn_smem + LDS_MAIN);
  if (threadIdx.x < 4) st[threadIdx.x] = 0u;
  __syncthreads();
  XcdBarrier xb = xcd_barrier_post((unsigned*)(p.ws + OFF_BAR), st);
  if (p.out == nullptr) grid.sync();
#pragma unroll 1
  for (int r = 0; r < REP_PREP; r++) {
    phase_prep(p, bid, nb, dyn_smem);
    xcd_barrier(xb);
  }
#pragma unroll 1
  for (int l = 0; l < 2; l++) {
#pragma unroll 1
    for (int r = 0; r < REP_ROWS; r++) {
      phase_rows(p, l, l, bid, nb, dyn_smem);
      xcd_barrier(xb);
    }
#pragma unroll 1
    for (int r = 0; r < REP_G1; r++) {
      phase_gemm<1>(p, l, bid, nb, dyn_smem);
      xcd_barrier(xb);
    }
#pragma unroll 1
    for (int r = 0; r < REP_MIX; r++) {
      phase_mix(p, l, bid, nb, dyn_smem);
      xcd_barrier(xb);
    }
#pragma unroll 1
    for (int r = 0; r < REP_G2; r++) {
      phase_gemm<2>(p, l, bid, nb, dyn_smem);
      xcd_barrier(xb);
    }
  }
  phase_rows(p, 2, 1, bid, nb, dyn_smem);
}

extern "C" void kernel_launch(void* const* d_in, const int* in_sizes, int n_in, void* d_out, int out_size, void* d_ws,
                              size_t ws_size, hipStream_t stream) {
  static int grid_blocks = 0;
  if (!grid_blocks) {
    int dev = 0, cus = 0, per_cu = 0;
    (void)hipGetDevice(&dev);
    (void)hipDeviceGetAttribute(&cus, hipDeviceAttributeMultiprocessorCount, dev);
    (void)hipFuncSetAttribute((const void*)mega_kernel, hipFuncAttributeMaxDynamicSharedMemorySize, LDS_BYTES);
    (void)hipOccupancyMaxActiveBlocksPerMultiprocessor(&per_cu, mega_kernel, 512, LDS_BYTES);
    if (per_cu < 1) per_cu = 1;
    if (per_cu > 1) per_cu = 1;
    grid_blocks = cus * per_cu;
  }
  Params p{};
  const float** pp = (const float**)&p;
  for (int i = 0; i < 28; i++) pp[i] = (const float*)d_in[i];
  p.out = (float*)d_out;
  p.ws = (char*)d_ws;
  (void)hipMemsetAsync((char*)d_ws + OFF_BAR, 0, 16384, stream);
  void* args[] = {&p};
  hipError_t e = hipLaunchCooperativeKernel((const void*)mega_kernel, dim3(grid_blocks), dim3(512), args, LDS_BYTES, stream);
  if (e != hipSuccess) fprintf(stderr, "cooperative launch failed: %s (grid %d)\n", hipGetErrorString(e), grid_blocks);
}
```

```cpp
#include <hip/hip_runtime.h>
#include <hip/hip_cooperative_groups.h>
#include <cstdio>
namespace cg = cooperative_groups;

#ifndef COOP
#define COOP 1
#endif

typedef unsigned short u16;
typedef __attribute__((ext_vector_type(8))) short bf16x8;
typedef __attribute__((ext_vector_type(4))) short bf16x4;
typedef __attribute__((ext_vector_type(4))) float f32x4;

#define DEV __device__ __forceinline__

struct Params {
  const float *x_prompt, *x_sample, *cache_k, *cache_v, *c, *c_ctx, *w_mod, *b_mod, *w_in, *gmlp_w, *gmlp_b,
      *pool_w, *pool_scale, *lambda_qk, *subln_w, *conv_w, *conv_b, *filt_w1, *filt_b1, *filt_w2, *filt_b2,
      *filt_freq, *filt_w3, *hyena_bias, *w_out, *b_out, *ln_g, *ln_b;
  float* out;
  char* ws;
};

constexpr int LDS_TEAM = 73728;
constexpr int LDS_MAIN = 2 * LDS_TEAM;
constexpr int LDS_BYTES = LDS_MAIN + 16;
constexpr size_t OFF_WINT = 0;
constexpr size_t OFF_WOUTT = OFF_WINT + 54525952;
constexpr size_t OFF_H = OFF_WOUTT + 16777216;
constexpr size_t OFF_P = OFF_H + 33554432;
constexpr size_t OFF_Y = OFF_P + 109051904;
constexpr size_t OFF_MOD = OFF_Y + 33554432;
constexpr size_t OFF_F0 = OFF_MOD + 245760;
constexpr size_t OFF_F1 = OFF_F0 + 2162688;
constexpr size_t OFF_FN = OFF_F1 + 8454144;
constexpr size_t OFF_ROPE = OFF_FN + 1048576;
constexpr size_t OFF_BAR = OFF_ROPE + 262144;
constexpr size_t OFF_CNT = OFF_BAR + 13824;
constexpr size_t OFF_KC = OFF_BAR + 16384;
constexpr size_t OFF_VC = OFF_KC + 4194304;
constexpr size_t OUT_YS = 8388608;
constexpr size_t OUT_K = 16777216;
constexpr size_t OUT_V = 16777216 + 4194304;

DEV u16 f2bf(float f) {
  unsigned u = __float_as_uint(f);
  u += 0x7fffu + ((u >> 16) & 1u);
  return (u16)(u >> 16);
}
DEV float bf2f(short h) { return __uint_as_float(((unsigned)(u16)h) << 16); }
DEV float silu(float x) { return x / (1.f + __expf(-x)); }
DEV bf16x8 pack8(const float* f) {
  bf16x8 o;
#pragma unroll
  for (int j = 0; j < 8; j++) o[j] = (short)f2bf(f[j]);
  return o;
}
DEV f32x4 mfma16(bf16x8 a, bf16x8 b, f32x4 c) { return __builtin_amdgcn_mfma_f32_16x16x32_bf16(a, b, c, 0, 0, 0); }
DEV bf16x8 tr_read2(unsigned a0, unsigned a1) {
  bf16x4 lo, hi;
  asm volatile("ds_read_b64_tr_b16 %0, %2\n\tds_read_b64_tr_b16 %1, %3\n\ts_waitcnt lgkmcnt(0)"
               : "=&v"(lo), "=&v"(hi)
               : "v"(a0), "v"(a1)
               : "memory");
  bf16x8 r;
  r[0] = lo[0]; r[1] = lo[1]; r[2] = lo[2]; r[3] = lo[3];
  r[4] = hi[0]; r[5] = hi[1]; r[6] = hi[2]; r[7] = hi[3];
  return r;
}
DEV void tr_read2x4(unsigned a0, unsigned a1, unsigned step, bf16x8 (&r)[4]) {
  bf16x4 l0, h0, l1, h1, l2, h2, l3, h3;
  const unsigned b0 = a0 + step, c0 = a1 + step, b1 = a0 + 2 * step, c1 = a1 + 2 * step, b2 = a0 + 3 * step, c2 = a1 + 3 * step;
  asm volatile(
      "ds_read_b64_tr_b16 %0, %8\n\tds_read_b64_tr_b16 %1, %9\n\t"
      "ds_read_b64_tr_b16 %2, %10\n\tds_read_b64_tr_b16 %3, %11\n\t"
      "ds_read_b64_tr_b16 %4, %12\n\tds_read_b64_tr_b16 %5, %13\n\t"
      "ds_read_b64_tr_b16 %6, %14\n\tds_read_b64_tr_b16 %7, %15\n\ts_waitcnt lgkmcnt(0)"
      : "=&v"(l0), "=&v"(h0), "=&v"(l1), "=&v"(h1), "=&v"(l2), "=&v"(h2), "=&v"(l3), "=&v"(h3)
      : "v"(a0), "v"(a1), "v"(b0), "v"(c0), "v"(b1), "v"(c1), "v"(b2), "v"(c2)
      : "memory");
  r[0] = (bf16x8){l0[0], l0[1], l0[2], l0[3], h0[0], h0[1], h0[2], h0[3]};
  r[1] = (bf16x8){l1[0], l1[1], l1[2], l1[3], h1[0], h1[1], h1[2], h1[3]};
  r[2] = (bf16x8){l2[0], l2[1], l2[2], l2[3], h2[0], h2[1], h2[2], h2[3]};
  r[3] = (bf16x8){l3[0], l3[1], l3[2], l3[3], h3[0], h3[1], h3[2], h3[3]};
}
DEV int launder_tid() {
  int t = threadIdx.x & 255;
  asm volatile("" : "+v"(t));
  return t;
}
DEV float wave_sum(float v) {
#pragma unroll
  for (int o = 32; o; o >>= 1) v += __shfl_xor(v, o);
  return v;
}
DEV float block_sum(float v, float* red) {
  v = wave_sum(v);
  __syncthreads();
  if ((threadIdx.x & 63) == 0) red[threadIdx.x >> 6] = v;
  __syncthreads();
  return red[0] + red[1] + red[2] + red[3];
}


#define XB_TMO 128
#define XB_XCNT(j) (256 + 64 * (j))
#define XB_XSUB(j) (1280 + 64 * (j))
#define XB_XGEN(j) (2304 + 64 * (j))
#define XB_TOP 3328
#define XB_TOPGEN 3392
#define XCD_BAR_WORDS 3456
#define XB_SPIN_CAP (1u << 22)
#define LAS __attribute__((address_space(3)))
DEV unsigned xb_ld(unsigned* p) { return __hip_atomic_load(p, __ATOMIC_RELAXED, __HIP_MEMORY_SCOPE_AGENT); }
DEV unsigned xb_add(unsigned* p, unsigned v) { return __hip_atomic_fetch_add(p, v, __ATOMIC_RELAXED, __HIP_MEMORY_SCOPE_AGENT); }
DEV unsigned xb_xcc_id() { return (unsigned)__builtin_amdgcn_s_getreg((3 << 11) | 20) & 0xFu; }
#define XB_SPIN(cond, bar) do { unsigned _sp = 0; while (cond) { __builtin_amdgcn_s_sleep(1); \
    if ((++_sp & 255u) == 0u) { if (xb_ld(&(bar)[XB_TMO])) break; if (_sp > XB_SPIN_CAP) { atomicAdd(&(bar)[XB_TMO], 1u); break; } } } } while (0)
struct XcdBarrier { unsigned* bar; unsigned x; volatile LAS unsigned* st; };
DEV XcdBarrier xcd_barrier_post(unsigned* bar, volatile LAS unsigned* st) {
  XcdBarrier b; b.bar = bar; b.x = xb_xcc_id(); b.st = st;
  if (threadIdx.x == 0) (void)xb_add(&bar[XB_XCNT(b.x)], 1u);
  return b;
}
DEV void xcd_barrier_complete(unsigned* bar, unsigned x, unsigned& nloc, unsigned& nx) {
  const unsigned G = gridDim.x * gridDim.y * gridDim.z;
  unsigned sum, cnt, mine, sp = 0u;
  for (;;) {
    sum = 0u; cnt = 0u; mine = 0u;
#pragma unroll
    for (unsigned j = 0; j < 16; ++j) { const unsigned c = xb_ld(&bar[XB_XCNT(j)]); sum += c; cnt += (c > 0u) ? 1u : 0u; mine = (j == x) ? c : mine; }
    if (sum == G) break;
    __builtin_amdgcn_s_sleep(1);
    if ((++sp & 255u) == 0u) { if (xb_ld(&bar[XB_TMO])) break; if (sp > XB_SPIN_CAP) { atomicAdd(&bar[XB_TMO], 1u); break; } }
  }
  nloc = mine > 0u ? mine : 1u; nx = cnt > 0u ? cnt : 1u;
}
DEV void xcd_barrier(const XcdBarrier& b) {
  asm volatile("s_waitcnt vmcnt(0)" ::: "memory");
  __syncthreads();
  if (threadIdx.x == 0) {
    unsigned* bar = b.bar;
    __builtin_amdgcn_s_waitcnt(0);
    unsigned nloc = b.st[0], nx = b.st[1];
    if (nloc == 0u) { xcd_barrier_complete(bar, b.x, nloc, nx); b.st[0] = nloc; b.st[1] = nx; }
    const unsigned old = xb_add(&bar[XB_XSUB(b.x)], 1u);
    const unsigned gen = old / nloc;
    if (old + 1u == (gen + 1u) * nloc) {
      __builtin_amdgcn_fence(__ATOMIC_RELEASE, "agent");
      asm volatile("s_waitcnt vmcnt(0)" ::: "memory");
      const unsigned og = xb_add(&bar[XB_TOP], 1u);
      const unsigned tg = og / nx;
      if (og + 1u == (tg + 1u) * nx) xb_add(&bar[XB_TOPGEN], 1u);
      else XB_SPIN(xb_ld(&bar[XB_TOPGEN]) == tg, bar);
      __builtin_amdgcn_fence(__ATOMIC_ACQUIRE, "agent");
      xb_add(&bar[XB_XGEN(b.x)], 1u);
      asm volatile("s_waitcnt vmcnt(0)" ::: "memory");
    } else {
      XB_SPIN(xb_ld(&bar[XB_XGEN(b.x)]) == gen, bar);
      __builtin_amdgcn_fence(__ATOMIC_ACQUIRE, "agent");
      asm volatile("s_waitcnt vmcnt(0)" ::: "memory");
    }
  }
  __syncthreads();
}

extern __shared__ __attribute__((aligned(16))) char dyn_smem[];

DEV void p0_transpose(const float* __restrict__ W, u16* __restrict__ WT, int K, int N, int kt, int nt, char* smem) {
  float* sm = (float*)smem;
  const int tid = launder_tid();
  const int k0 = kt * 64, n0 = nt * 256;
  float4 v[16];
#pragma unroll
  for (int i = 0; i < 16; i++) {
    int r = (tid >> 6) + i * 4, c4 = tid & 63;
    v[i] = *(const float4*)(W + (size_t)(k0 + r) * N + n0 + c4 * 4);
  }
#pragma unroll
  for (int i = 0; i < 16; i++) {
    int r = (tid >> 6) + i * 4, c4 = tid & 63;
    float* d = sm + r * 257 + c4 * 4;
    d[0] = v[i].x; d[1] = v[i].y; d[2] = v[i].z; d[3] = v[i].w;
  }
  __syncthreads();
#pragma unroll
  for (int i = 0; i < 8; i++) {
    int ch = tid + i * 256, kc = ch & 7, n = ch >> 3;
    float f[8];
#pragma unroll
    for (int j = 0; j < 8; j++) f[j] = sm[(kc * 8 + j) * 257 + n];
    *(bf16x8*)(WT + (size_t)(n0 + n) * K + k0 + kc * 8) = pack8(f);
  }
  __syncthreads();
}

DEV void p0_mod(const Params& p, int l, int cgp, char* smem) {
  float* s = (float*)smem;
  float* red = s + 10240;
  const int tid = launder_tid();
  for (int i = tid; i < 10240; i += 256) {
    int r = i >> 11, k = i & 2047;
    float cv = (r == 0) ? p.c_ctx[k] : p.c[(r - 1) * 2048 + k];
    s[i] = cv / (1.f + expf(-cv));
  }
  __syncthreads();
  const int cq = tid & 15, ks = tid >> 4;
  const float* W = p.w_mod + (size_t)l * 2048 * 6144 + cgp * 64 + cq * 4;
  float acc[5][4];
#pragma unroll
  for (int r = 0; r < 5; r++)
#pragma unroll
    for (int e = 0; e < 4; e++) acc[r][e] = 0.f;
#pragma unroll 8
  for (int k = ks * 128; k < ks * 128 + 128; k++) {
    float4 w = *(const float4*)(W + (size_t)k * 6144);
#pragma unroll
    for (int r = 0; r < 5; r++) {
      float sv = s[r * 2048 + k];
      acc[r][0] += sv * w.x; acc[r][1] += sv * w.y; acc[r][2] += sv * w.z; acc[r][3] += sv * w.w;
    }
  }
#pragma unroll
  for (int r = 0; r < 5; r++)
#pragma unroll
    for (int e = 0; e < 4; e++) red[(ks * 5 + r) * 64 + cq * 4 + e] = acc[r][e];
  __syncthreads();
  float* MOD = (float*)(p.ws + OFF_MOD);
  for (int i = tid; i < 320; i += 256) {
    int r = i >> 6, col = i & 63;
    float sum = 0.f;
#pragma unroll
    for (int k2 = 0; k2 < 16; k2++) sum += red[(k2 * 5 + r) * 64 + col];
    sum += p.b_mod[l * 6144 + cgp * 64 + col];
    MOD[(l * 5 + r) * 6144 + cgp * 64 + col] = sum;
  }
  __syncthreads();
}

DEV void p0_filter(const Params& p, int l, int path, int chunk, int q, char* smem) {
  const int L = path ? 1024 : 256;
  const int XLEN = 2 * L + 16;
  float* w1s = (float*)smem;
  float* w2s = w1s + 2112;
  float* feats = w2s + 4096;
  float* h1 = feats + 1056;
  float* h2 = h1 + 2048;
  u16* tile = (u16*)smem;
  const int tid = launder_tid();
  const int o = q >> 1, dir = q & 1;
  float* b1 = h2 + 2048;
  float* b2 = b1 + 64;
  float* fr = b2 + 64;
  const float invLm1 = 1.f / (float)(L - 1);
  __syncthreads();
  if (tid < 64) { b1[tid] = p.filt_b1[l * 64 + tid]; b2[tid] = p.filt_b2[l * 64 + tid]; fr[tid] = p.filt_freq[l * 64 + tid]; }
  for (int i = tid; i < 2112; i += 256) w1s[i] = p.filt_w1[l * 2112 + i];
  for (int i = tid; i < 4096; i += 256) w2s[i] = p.filt_w2[l * 4096 + i];
  for (int e = tid; e < 1056; e += 256) {
    int t = e / 33, f = e - t * 33;
    int tg = chunk * 32 + t;
    float v;
    if (f == 0) v = (float)tg * invLm1;
    else {
      int bb = (f - 1) & 15;
      float band = 1e-4f + (float)bb * ((15.f - 1e-4f) / 15.f);
      float ang = (6.283185307179586f * (float)tg / (float)L) * band;
      v = (f <= 16) ? cosf(ang) : sinf(ang);
    }
    feats[e] = v;
  }
  __syncthreads();
  {
    int t = tid >> 3, j0 = (tid & 7) * 8;
    float a[8];
#pragma unroll
    for (int k = 0; k < 8; k++) a[k] = b1[j0 + k];
#pragma unroll 3
    for (int f = 0; f < 33; f++) {
      float fv = feats[t * 33 + f];
#pragma unroll
      for (int k = 0; k < 8; k++) a[k] += fv * w1s[f * 64 + j0 + k];
    }
#pragma unroll
    for (int k = 0; k < 8; k++) h1[t * 64 + j0 + k] = sinf(fr[j0 + k] * a[k]);
  }
  __syncthreads();
  {
    int t = tid >> 3, j0 = (tid & 7) * 8;
    float a[8];
#pragma unroll
    for (int k = 0; k < 8; k++) a[k] = b2[j0 + k];
#pragma unroll 4
    for (int f = 0; f < 64; f++) {
      float fv = h1[t * 64 + f];
#pragma unroll
      for (int k = 0; k < 8; k++) a[k] += fv * w2s[f * 64 + j0 + k];
    }
#pragma unroll
    for (int k = 0; k < 8; k++) h2[t * 64 + j0 + k] = sinf(fr[j0 + k] * a[k]);
  }
  __syncthreads();
  const float da = logf(1e-2f) / 0.3f, db = logf(1e-2f) / 1.5f;
  float* FNP = (float*)(p.ws + OFF_FN);
#pragma unroll 1
  for (int cc = 0; cc < 2; cc++) {
    const int ch = tid + cc * 256;
    const float* w3 = p.filt_w3 + (size_t)l * 64 * 2048 + q * 512 + ch;
    float w3r[64];
#pragma unroll
    for (int j = 0; j < 64; j++) w3r[j] = w3[j * 2048];
    const float delta = fabsf(da + (db - da) * ((float)ch / 511.f));
    float asum = 0.f;
#pragma unroll 2
    for (int t = 0; t < 32; t++) {
      const int tg = chunk * 32 + t;
      float acc = 0.f;
      int toff = t * 64;
      asm volatile("" : "+v"(toff));
      const float* hp = h2 + toff;
#pragma unroll
      for (int j4 = 0; j4 < 16; j4++) {
        float4 hv = *(const float4*)(hp + j4 * 4);
        acc += hv.x * w3r[j4 * 4] + hv.y * w3r[j4 * 4 + 1] + hv.z * w3r[j4 * 4 + 2] + hv.w * w3r[j4 * 4 + 3];
      }
      float v = acc * expf(-(float)tg * invLm1 * delta);
      if (dir == 0 || tg >= 1) asum += fabsf(v);
      tile[ch * 34 + t] = f2bf(v);
    }
    FNP[((((path * 2 + l) * 4 + q) * 32) + chunk) * 512 + ch] = asum;
  }
  __syncthreads();
  u16* Fb = (u16*)(p.ws + (path ? OFF_F1 : OFF_F0));
  {
    const int hw = tid >> 5, t = tid & 31;
    const int tg = chunk * 32 + t;
    const int x = dir ? L + tg : L - tg;
    const bool ok = (dir == 0) || (tg >= 1);
    for (int ch = hw; ch < 512; ch += 8) {
      if (ok) Fb[((size_t)((l * 2 + o) * 512 + ch)) * XLEN + x] = tile[ch * 34 + t];
    }
  }
  if (chunk == 0) {
    if (dir == 0) {
      for (int ch = tid; ch < 512; ch += 256) Fb[((size_t)((l * 2 + o) * 512 + ch)) * XLEN] = 0;
    } else {
      for (int e = tid; e < 512 * 16; e += 256) Fb[((size_t)((l * 2 + o) * 512 + (e >> 4))) * XLEN + 2 * L + (e & 15)] = 0;
    }
  }
  __syncthreads();
}

DEV void p0_rope(const Params& p, int item) {
  int idx = item * 256 + (threadIdx.x & 255);
  int t = idx >> 5, f = idx & 31;
  int fi = f & 15;
  float inv = powf(10000.f, -(float)(2 * fi) / 32.f);
  float pos = (f < 16) ? (float)(t >> 6) : (float)(t & 63);
  float ang = pos * inv;
  float2 cs;
  cs.x = cosf(ang);
  cs.y = sinf(ang);
  ((float2*)(p.ws + OFF_ROPE))[idx] = cs;
}

DEV void phase_prep(const Params& p, int bid, int nb, char* smem) {
  constexpr int N_MOD = 192, N_FILT = 320, N_TIN = 832, N_TOUT = 256, N_ROPE = 128, N_CVT = 512;
  constexpr int TOT = N_MOD + N_FILT + N_TIN + N_TOUT + N_ROPE + N_CVT;
  const int team = __builtin_amdgcn_readfirstlane(threadIdx.x >> 8);
  smem += team * LDS_TEAM;
  volatile LAS unsigned* stq = (volatile LAS unsigned*)(dyn_smem + LDS_MAIN);
  unsigned* cnt = (unsigned*)(p.ws + OFF_CNT);
  for (;;) {
    __syncthreads();
    if (threadIdx.x == 0) stq[2] = atomicAdd(cnt, 1u);
    __syncthreads();
    const int jp = (int)stq[2];
    if (jp >= TOT / 2) break;
    int i = jp * 2 + team;
    if (i < N_MOD) { p0_mod(p, i / 96, i % 96, smem); continue; }
    i -= N_MOD;
    if (i < N_FILT) {
      if (i < 256) p0_filter(p, i >> 7, 1, (i >> 2) & 31, i & 3, smem);
      else { int k = i - 256; p0_filter(p, k >> 5, 0, (k >> 2) & 7, k & 3, smem); }
      continue;
    }
    i -= N_FILT;
    if (i < N_TIN) {
      int nt = i % 26, kt = i / 26;
      p0_transpose(p.w_in, (u16*)(p.ws + OFF_WINT), 2048, 6656, kt, nt, smem);
      continue;
    }
    i -= N_TIN;
    if (i < N_TOUT) {
      int nt = i % 8, kt = i / 8;
      p0_transpose(p.w_out, (u16*)(p.ws + OFF_WOUTT), 2048, 2048, kt, nt, smem);
      continue;
    }
    i -= N_TOUT;
    if (i < N_ROPE) { p0_rope(p, i); continue; }
    i -= N_ROPE;
    {
      const float* src = (i < 256) ? p.cache_k : p.cache_v;
      u16* dst = (u16*)(p.ws + ((i < 256) ? OFF_KC : OFF_VC));
      const int tl = threadIdx.x & 255;
      const size_t base = (size_t)(i & 255) * 8192;
#pragma unroll
      for (int e = 0; e < 4; e++) {
        const size_t o = base + (size_t)(e * 256 + tl) * 8;
        float4 a = *(const float4*)(src + o), c2 = *(const float4*)(src + o + 4);
        float f[8] = {a.x, a.y, a.z, a.w, c2.x, c2.y, c2.z, c2.w};
        *(bf16x8*)(dst + o) = pack8(f);
      }
    }
  }
}

DEV void phase_rows(const Params& p, int mode, int l, int bid, int nb, char* smem) {
  int tr0 = threadIdx.x;
  asm volatile("" : "+v"(tr0));
  const int lane = tr0 & 63, wave = tr0 >> 6;
  const float* MOD = (const float*)(p.ws + OFF_MOD);
  const float* PRE = (const float*)(p.ws + OFF_P);
  u16* H = (u16*)(p.ws + OFF_H);
  for (int row = bid * 8 + wave; row < 8192; row += nb * 8) {
    float4 v[8];
    if (mode == 0) {
      const float* src = (row < 4096) ? p.x_prompt + (size_t)row * 2048 : p.x_sample + (size_t)(row - 4096) * 2048;
#pragma unroll
      for (int k = 0; k < 8; k++) v[k] = *(const float4*)(src + k * 256 + lane * 4);
    } else {
      const u16* src = (const u16*)PRE + (size_t)row * 2048;
#pragma unroll
      for (int k = 0; k < 8; k++) {
        bf16x4 h4 = *(const bf16x4*)(src + k * 256 + lane * 4);
        v[k] = make_float4(bf2f(h4[0]), bf2f(h4[1]), bf2f(h4[2]), bf2f(h4[3]));
      }
    }
    if (mode != 0) {
      const int lp = (mode == 1) ? l - 1 : 1;
      float s = 0.f;
#pragma unroll
      for (int k = 0; k < 8; k++) s += v[k].x + v[k].y + v[k].z + v[k].w;
      const float mean = wave_sum(s) * (1.f / 2048.f);
      float q = 0.f;
#pragma unroll
      for (int k = 0; k < 8; k++) {
        v[k].x -= mean; v[k].y -= mean; v[k].z -= mean; v[k].w -= mean;
        q += v[k].x * v[k].x + v[k].y * v[k].y + v[k].z * v[k].z + v[k].w * v[k].w;
      }
      const float rstd = rsqrtf(wave_sum(q) * (1.f / 2048.f) + 1e-6f);
      const float* g = p.ln_g + lp * 2048;
      const float* bb = p.ln_b + lp * 2048;
#pragma unroll
      for (int k = 0; k < 8; k++) {
        const int c0 = k * 256 + lane * 4;
        float4 g4 = *(const float4*)(g + c0), b4 = *(const float4*)(bb + c0);
        v[k].x = v[k].x * rstd * g4.x + b4.x; v[k].y = v[k].y * rstd * g4.y + b4.y;
        v[k].z = v[k].z * rstd * g4.z + b4.z; v[k].w = v[k].w * rstd * g4.w + b4.w;
        *(float4*)(p.out + (size_t)row * 2048 + c0) = v[k];
      }
      if (mode == 2) continue;
    }
    float s = 0.f;
#pragma unroll
    for (int k = 0; k < 8; k++) s += v[k].x + v[k].y + v[k].z + v[k].w;
    const float mean = wave_sum(s) * (1.f / 2048.f);
    float q = 0.f;
#pragma unroll
    for (int k = 0; k < 8; k++) {
      v[k].x -= mean; v[k].y -= mean; v[k].z -= mean; v[k].w -= mean;
      q += v[k].x * v[k].x + v[k].y * v[k].y + v[k].z * v[k].z + v[k].w * v[k].w;
    }
    const float rstd = rsqrtf(wave_sum(q) * (1.f / 2048.f) + 1e-6f);
    const int r = row < 4096 ? 0 : 1 + ((row - 4096) >> 10);
    const float* md = MOD + (l * 5 + r) * 6144;
#pragma unroll
    for (int k = 0; k < 8; k++) {
      const int c0 = k * 256 + lane * 4;
      float4 sh = *(const float4*)(md + c0), sc = *(const float4*)(md + 2048 + c0);
      bf16x4 o;
      o[0] = (short)f2bf(v[k].x * rstd * (1.f + sc.x) + sh.x);
      o[1] = (short)f2bf(v[k].y * rstd * (1.f + sc.y) + sh.y);
      o[2] = (short)f2bf(v[k].z * rstd * (1.f + sc.z) + sh.z);
      o[3] = (short)f2bf(v[k].w * rstd * (1.f + sc.w) + sh.w);
      *(bf16x4*)(H + (size_t)row * 2048 + c0) = o;
    }
  }
}


namespace pg8 {
#define PG8_LAS __attribute__((address_space(3)))
typedef unsigned short bf16_t;
typedef short bf16x8 __attribute__((ext_vector_type(8)));
typedef float f32x4 __attribute__((ext_vector_type(4)));
typedef unsigned u32x4 __attribute__((ext_vector_type(4)));
constexpr int BM = 256, BK = 64, HALF = 128, HTB = HALF * BK * 2  , STAGE_BYTES = 8 * HTB, NXCD = 8, WGM = 8;

__host__ __device__ __forceinline__ int lds_byte(int r, int c) { const int st = (r >> 4) * 2 + (c >> 5), rr = r & 15, cc = c & 31, ob = rr * 64 + cc * 2; return st * 1024 + (ob ^ (((ob >> 9) & 1) << 5)); }
__host__ __device__ __forceinline__ void stage_rc(int b, int& R, int& C) { const int st = b / 1024, sb = b % 1024, swz = sb ^ (((sb >> 9) & 1) << 5); R = (st >> 1) * 16 + swz / 64; C = (st & 1) * 32 + (swz % 64) / 2; }
__host__ __device__ __forceinline__ int perm32(int rho) { const int n = rho >> 4, i = rho & 15; return 8 * (i >> 2) + 4 * n + (i & 3); }

struct Unit { int pm, pn; };
struct Gemm { const bf16_t* A; const bf16_t* Bt; int M, N, K; };

struct StaticOrder {
    int nM, nN, nwg, G, c;
    __host__ __device__ void init(int M, int N, int G_, int c_) { nM = M / BM; nN = N / BM; nwg = nM * nN; G = G_; c = c_; }
    __host__ __device__ bool next(int i, Unit& u) const {
        const long L = (long)i * G + c; if (L >= nwg) return false;
        int wgid = (int)L; { const int q = nwg / NXCD, r = nwg % NXCD, xcd = wgid % NXCD, off = wgid / NXCD; wgid = (xcd < r ? xcd * (q + 1) : r * (q + 1) + (xcd - r) * q) + off; }
        const int nig = WGM * nN, gid = wgid / nig, fm = gid * WGM, gsz = (nM - fm) < WGM ? (nM - fm) : WGM;
        u.pm = fm + ((wgid % nig) % gsz); u.pn = (wgid % nig) / gsz; return true;
    }
    __device__ __forceinline__ void a_ready(const Unit&) const {}
    __device__ __forceinline__ void done(const Unit&) const {}
};

__device__ __forceinline__ unsigned cvt_pk_bf16(float lo, float hi) { unsigned r; asm volatile("v_cvt_pk_bf16_f32 %0, %1, %2" : "=v"(r) : "v"(lo), "v"(hi)); return r; }


template <class Epi, class Sched, bool STAMP = false>
__device__ __forceinline__ void gemm_phase(PG8_LAS unsigned char* lds, const Gemm g, const Sched& S, const Epi& E, unsigned long long* stamps) {
    int tid0 = threadIdx.x; asm volatile("" : "+v"(tid0));
    const int tid = tid0, wid = __builtin_amdgcn_readfirstlane(tid >> 6), lane = tid & 63, wr = wid >> 2, wc = wid & 3, fr = lane & 15, fq = lane >> 4;
    const int K = g.K, nt = K / BK;
    int ts_lo = 0, ts_hi = 0, nts = 0; const unsigned long long rt_entry = STAMP ? (unsigned long long)wall_clock64() : 0ull;
#define PG8_STAMP() do { if (STAMP && wid == 0 && nts < 64) { const unsigned long long _c = (unsigned long long)clock64(); \
        ts_lo = (lane == nts) ? (int)(unsigned)_c : ts_lo; ts_hi = (lane == nts) ? (int)(unsigned)(_c >> 32) : ts_hi; ++nts; } } while (0)
    PG8_STAMP();
    unsigned voffA[2], voffB[2];
#pragma unroll
    for (int i = 0; i < 2; ++i) { int R, C; stage_rc(tid * 16 + i * 8192, R, C); const int Rb = Epi::PERM ? ((R & ~31) + perm32(R & 31)) : R;
        voffA[i] = (unsigned)(R * K + C) * 2u; voffB[i] = (unsigned)(Rb * K + C) * 2u; }
    const size_t kstep = (size_t)(BK * 2);
    const size_t hstep = (size_t)HALF * K * 2;
    const size_t tstep = 2 * hstep;
    const unsigned ldsw = (unsigned)wid * 1024u;
    const int aoff = lds_byte(wr * 64 + fr, fq * 8), boff = lds_byte(wc * 32 + fr, fq * 8);
#define PG8_SA(b, h) (((b) * 2 + (h)) * HTB)
#define PG8_SB(b, h) ((4 + (b) * 2 + (h)) * HTB)
#define PG8_STAGE(bufoff, gbase, voff) do { _Pragma("unroll") for (int _i = 0; _i < 2; ++_i) \
        __builtin_amdgcn_global_load_lds((const unsigned*)((const char*)(gbase) + (voff)[_i]), (PG8_LAS unsigned*)(lds + (bufoff) + ldsw + _i * 8192), 16, 0, 0); } while (0)
#define PG8_LDA(dst, b, h) do { _Pragma("unroll") for (int m = 0; m < 4; ++m) _Pragma("unroll") for (int k = 0; k < 2; ++k) dst[m][k] = *(const PG8_LAS bf16x8*)(lds + PG8_SA(b, h) + aoff + m * 2048 + k * 1024); } while (0)
#define PG8_LDB(dst, b, h) do { _Pragma("unroll") for (int n = 0; n < 2; ++n) _Pragma("unroll") for (int k = 0; k < 2; ++k) dst[n][k] = *(const PG8_LAS bf16x8*)(lds + PG8_SB(b, h) + boff + n * 2048 + k * 1024); } while (0)
#define PG8_MMA(ai, bj, At, Bt) do { __builtin_amdgcn_s_setprio(1); _Pragma("unroll") for (int m = 0; m < 4; ++m) _Pragma("unroll") for (int n = 0; n < 2; ++n) _Pragma("unroll") for (int k = 0; k < 2; ++k) \
        acc[ai][bj][m][n] = __builtin_amdgcn_mfma_f32_16x16x32_bf16(Bt[n][k], At[m][k], acc[ai][bj][m][n], 0, 0, 0); __builtin_amdgcn_s_setprio(0); } while (0)
#define PG8_WAIT_V(n) asm volatile("s_waitcnt vmcnt(" #n ")" ::: "memory")
#define PG8_WAIT_L(n) asm volatile("s_waitcnt lgkmcnt(" #n ")" ::: "memory")
#define PG8_BAR __builtin_amdgcn_s_barrier()
#define PG8_SCHED __builtin_amdgcn_sched_barrier(0)
    Unit cur, nxt; int ui = 0;
    if (!S.next(0, cur)) return;
    f32x4 acc[2][2][4][2];
#pragma unroll
    for (int a = 0; a < 2; ++a)
#pragma unroll
        for (int b = 0; b < 2; ++b)
#pragma unroll
            for (int m = 0; m < 4; ++m)
#pragma unroll
                for (int n = 0; n < 2; ++n) acc[a][b][m][n] = (f32x4){0.f, 0.f, 0.f, 0.f};
    bf16x8 At[4][2], B0[2][2], B1[2][2];
    const char* cA = (const char*)g.A + (size_t)cur.pm * tstep; const char* cB = (const char*)g.Bt + (size_t)cur.pn * tstep;
    S.a_ready(cur);
    PG8_STAGE(PG8_SB(0, 0), cB, voffB); PG8_STAGE(PG8_SA(0, 0), cA, voffA); PG8_STAGE(PG8_SB(0, 1), cB + hstep, voffB); PG8_STAGE(PG8_SA(0, 1), cA + hstep, voffA);
    if (wr == 1) PG8_BAR;
    PG8_WAIT_V(4); PG8_BAR;
    PG8_STAGE(PG8_SB(1, 0), cB + kstep, voffB); PG8_STAGE(PG8_SA(1, 0), cA + kstep, voffA); PG8_STAGE(PG8_SB(1, 1), cB + hstep + kstep, voffB);
    PG8_WAIT_V(6); PG8_BAR;
    PG8_STAMP();
    for (;;) {
        const bool has_next = S.next(ui + 1, nxt);
        const char* nA = has_next ? (const char*)g.A + (size_t)nxt.pm * tstep : cA; const char* nB = has_next ? (const char*)g.Bt + (size_t)nxt.pn * tstep : cB;
        for (int t = 0; t < nt; t += 2) {
            const bool last = (t == nt - 2);
            const char* a1 = cA + (size_t)(t + 1) * kstep;
            const char* a2 = last ? nA : cA + (size_t)(t + 2) * kstep; const char* b2 = last ? nB : cB + (size_t)(t + 2) * kstep;
            const char* a3 = a2 + kstep; const char* b3 = b2 + kstep;
            if (last && has_next) S.a_ready(nxt);
            PG8_LDB(B0, 0, 0); PG8_SCHED; PG8_LDA(At, 0, 0); PG8_STAGE(PG8_SA(1, 1), a1 + hstep, voffA);
            PG8_WAIT_L(8); PG8_BAR; PG8_WAIT_L(0); PG8_MMA(0, 0, At, B0); PG8_BAR; PG8_SCHED;
            PG8_LDB(B1, 0, 1); PG8_STAGE(PG8_SB(0, 0), b2, voffB);
            PG8_BAR; PG8_WAIT_L(0); PG8_MMA(0, 1, At, B1); PG8_BAR;
            PG8_LDA(At, 0, 1); PG8_STAGE(PG8_SA(0, 0), a2, voffA);
            PG8_BAR; PG8_WAIT_L(0); PG8_MMA(1, 0, At, B0); PG8_BAR; PG8_SCHED;
            PG8_STAGE(PG8_SB(0, 1), b2 + hstep, voffB);
            PG8_WAIT_V(6); PG8_BAR; PG8_MMA(1, 1, At, B1); PG8_BAR;
            PG8_LDB(B0, 1, 0); PG8_SCHED; PG8_LDA(At, 1, 0); PG8_STAGE(PG8_SA(0, 1), a2 + hstep, voffA);
            PG8_WAIT_L(8); PG8_BAR; PG8_WAIT_L(0); PG8_MMA(0, 0, At, B0); PG8_BAR; PG8_SCHED;
            PG8_LDB(B1, 1, 1); PG8_STAGE(PG8_SB(1, 0), b3, voffB);
            PG8_BAR; PG8_WAIT_L(0); PG8_MMA(0, 1, At, B1); PG8_BAR;
            PG8_LDA(At, 1, 1); PG8_STAGE(PG8_SA(1, 0), a3, voffA);
            PG8_BAR; PG8_WAIT_L(0); PG8_MMA(1, 0, At, B0); PG8_BAR; PG8_SCHED;
            PG8_STAGE(PG8_SB(1, 1), b3 + hstep, voffB);
            PG8_WAIT_V(6); PG8_BAR; PG8_MMA(1, 1, At, B1); PG8_BAR;
        }
        PG8_STAMP();
        if constexpr (!Epi::AFTER_DRAIN) { E(acc, cur, wr, wc, fr, fq); S.done(cur); }
        PG8_STAMP();
        if (!has_next) break;
#pragma unroll
        for (int a = 0; a < 2; ++a)
#pragma unroll
            for (int b = 0; b < 2; ++b)
#pragma unroll
                for (int m = 0; m < 4; ++m)
#pragma unroll
                    for (int n = 0; n < 2; ++n) acc[a][b][m][n] = (f32x4){0.f, 0.f, 0.f, 0.f};
        cur = nxt; cA = nA; cB = nB; ++ui;
    }
    PG8_WAIT_V(0);
    if (wr == 0) PG8_BAR;
    PG8_BAR;
    if constexpr (Epi::AFTER_DRAIN) { E.fused(acc, cur, wr, wc, fr, fq, lds, wid, lane); S.done(cur); }
    PG8_STAMP();
    if (STAMP && wid == 0) { stamps[lane] = lane < nts ? (((unsigned long long)(unsigned)ts_hi << 32) | (unsigned)ts_lo) : 0ull;
        if (lane == 62) stamps[62] = rt_entry; if (lane == 63) stamps[63] = (unsigned long long)wall_clock64(); }
#undef PG8_STAMP
#undef PG8_SA
#undef PG8_SB
#undef PG8_STAGE
#undef PG8_LDA
#undef PG8_LDB
#undef PG8_MMA
#undef PG8_WAIT_V
#undef PG8_WAIT_L
#undef PG8_BAR
#undef PG8_SCHED
}
}

struct EpiG1 {
  static constexpr bool PERM = true, AFTER_DRAIN = false;
  u16* P; float* out; const float2* ROPE; int l; int colbase;
  __device__ __forceinline__ void operator()(const pg8::f32x4 (&acc)[2][2][4][2], const pg8::Unit& u, int wr, int wc, int fr, int fq) const {
    const int piece = (colbase + u.pn * 256) >> 9;
    const bool latent = u.pm >= 16;
    const bool rope = latent && (piece == 5 || piece == 6);
    const bool kvout = !latent && (piece == 6 || piece == 7);
    const int row0 = u.pm * 256 + wr * 64 + fr, col0 = colbase + u.pn * 256 + wc * 32 + 8 * fq;
    const bool hi = fq >= 2;
#pragma unroll
    for (int ai = 0; ai < 2; ++ai)
#pragma unroll
      for (int m = 0; m < 4; ++m) {
        const int row = row0 + ai * 128 + m * 16;
        float4 cs[4];
        if (rope) {
          const int t = (row - 4096) & 1023;
          const float4* rp = (const float4*)(ROPE + t * 32 + (wc & 1) * 16 + 8 * (fq & 1));
          cs[0] = rp[0]; cs[1] = rp[1]; cs[2] = rp[2]; cs[3] = rp[3];
        }
        u16* prow = P + (size_t)row * 6656 + col0;
#pragma unroll
        for (int bj = 0; bj < 2; ++bj) {
          pg8::f32x4 v0 = acc[ai][bj][m][0], v1 = acc[ai][bj][m][1];
          if (rope) {
            float mine[8] = {v0[0], v0[1], v0[2], v0[3], v1[0], v1[1], v1[2], v1[3]};
            float cc[8] = {cs[0].x, cs[0].z, cs[1].x, cs[1].z, cs[2].x, cs[2].z, cs[3].x, cs[3].z};
            float sn[8] = {cs[0].y, cs[0].w, cs[1].y, cs[1].w, cs[2].y, cs[2].w, cs[3].y, cs[3].w};
            float res[8];
#pragma unroll
            for (int e = 0; e < 8; ++e) {
              const float other = __shfl_xor(mine[e], 32);
              res[e] = hi ? (mine[e] * cc[e] + other * sn[e]) : (mine[e] * cc[e] - other * sn[e]);
            }
            v0 = (pg8::f32x4){res[0], res[1], res[2], res[3]};
            v1 = (pg8::f32x4){res[4], res[5], res[6], res[7]};
          }
          pg8::u32x4 w;
          w.x = pg8::cvt_pk_bf16(v0[0], v0[1]); w.y = pg8::cvt_pk_bf16(v0[2], v0[3]);
          w.z = pg8::cvt_pk_bf16(v1[0], v1[1]); w.w = pg8::cvt_pk_bf16(v1[2], v1[3]);
          *(pg8::u32x4*)(prow + bj * 128) = w;
          if (kvout) {
            const int bb = row >> 8, t = row & 255;
            float* o = out + (piece == 6 ? OUT_K : OUT_V) + ((size_t)((bb * 2 + l) * 256 + t)) * 512 + (col0 + bj * 128 - piece * 512);
            *(pg8::f32x4*)o = v0;
            *(pg8::f32x4*)(o + 4) = v1;
          }
        }
      }
  }
};
struct EpiG2 {
  static constexpr bool PERM = false, AFTER_DRAIN = false;
  u16* PRE; const float* MOD; const float* xp; const float* xs; const float* xo; const float* bo; int l;
  __device__ __forceinline__ void operator()(const pg8::f32x4 (&acc)[2][2][4][2], const pg8::Unit& u, int wr, int wc, int fr, int fq) const {
    const float alpha = 1.41421356237f;
    const int row0 = u.pm * 256 + wr * 64 + fr, col0 = u.pn * 256 + wc * 32 + 4 * fq;
    const int r = u.pm < 16 ? 0 : 1 + ((u.pm - 16) >> 2);
    const float* gate = MOD + (l * 5 + r) * 6144 + 4096 + col0;
    const float* xbase = (l == 0) ? ((u.pm < 16) ? xp : xs - (size_t)4096 * 2048) : xo;
    pg8::f32x4 bv[2][2], gv[2][2];
#pragma unroll
    for (int bj = 0; bj < 2; ++bj)
#pragma unroll
      for (int n = 0; n < 2; ++n) {
        bv[bj][n] = *(const pg8::f32x4*)(bo + l * 2048 + col0 + bj * 128 + n * 16);
        gv[bj][n] = *(const pg8::f32x4*)(gate + bj * 128 + n * 16);
      }
#pragma unroll
    for (int ai = 0; ai < 2; ++ai)
#pragma unroll
      for (int mp = 0; mp < 2; ++mp) {
        pg8::f32x4 x4[2][2][2];
#pragma unroll
        for (int mm = 0; mm < 2; ++mm)
#pragma unroll
          for (int bj = 0; bj < 2; ++bj)
#pragma unroll
            for (int n = 0; n < 2; ++n)
              x4[mm][bj][n] = *(const pg8::f32x4*)(xbase + (size_t)(row0 + ai * 128 + (mp * 2 + mm) * 16) * 2048 + col0 + bj * 128 + n * 16);
#pragma unroll
        for (int mm = 0; mm < 2; ++mm) {
          const int m = mp * 2 + mm;
          u16* dst = PRE + (size_t)(row0 + ai * 128 + m * 16) * 2048 + col0;
#pragma unroll
          for (int bj = 0; bj < 2; ++bj)
#pragma unroll
            for (int n = 0; n < 2; ++n) {
              const pg8::f32x4 r4 = alpha * x4[mm][bj][n] + gv[bj][n] * (acc[ai][bj][m][n] + bv[bj][n]);
              uint2 w;
              w.x = pg8::cvt_pk_bf16(r4[0], r4[1]); w.y = pg8::cvt_pk_bf16(r4[2], r4[3]);
              *(uint2*)(dst + bj * 128 + n * 16) = w;
            }
        }
      }
  }
};

template <int MODE>
DEV void phase_gemm(const Params& p, int l, int bid, int nb, char* smem) {
  pg8::Gemm g;
  pg8::StaticOrder S;
  PG8_LAS unsigned char* lds = (PG8_LAS unsigned char*)smem;
  if (MODE == 1) {
    g.A = (const u16*)(p.ws + OFF_H); g.Bt = (const u16*)(p.ws + OFF_WINT) + (size_t)l * 6656 * 2048; g.M = 8192; g.N = 6144; g.K = 2048;
    S.init(8192, 6144, nb, bid);
    EpiG1 E; E.P = (u16*)(p.ws + OFF_P); E.out = p.out; E.ROPE = (const float2*)(p.ws + OFF_ROPE); E.l = l; E.colbase = 0;
    pg8::gemm_phase<EpiG1, pg8::StaticOrder, false>(lds, g, S, E, nullptr);
  } else {
    g.A = (const u16*)(p.ws + OFF_Y); g.Bt = (const u16*)(p.ws + OFF_WOUTT) + (size_t)l * 2048 * 2048; g.M = 8192; g.N = 2048; g.K = 2048;
    S.init(8192, 2048, nb, bid);
    EpiG2 E; E.PRE = (u16*)(p.ws + OFF_P); E.MOD = (const float*)(p.ws + OFF_MOD); E.xp = p.x_prompt; E.xs = p.x_sample; E.xo = p.out; E.bo = p.b_out; E.l = l;
    pg8::gemm_phase<EpiG2, pg8::StaticOrder, false>(lds, g, S, E, nullptr);
  }
}

struct OneUnit {
  int pm, pn;
  __device__ bool next(int i, pg8::Unit& u) const { if (i) return false; u.pm = pm; u.pn = pn; return true; }
  __device__ __forceinline__ void a_ready(const pg8::Unit&) const {}
  __device__ __forceinline__ void done(const pg8::Unit&) const {}
};
constexpr int FLG_WORD0 = 256;
DEV void gemm1_tail_unit(const Params& p, int l, int ti) {
  const int pm = ti & 31, pn = ti >> 5;
  pg8::Gemm g;
  g.A = (const u16*)(p.ws + OFF_H); g.Bt = (const u16*)(p.ws + OFF_WINT) + (size_t)l * 6656 * 2048 + (size_t)6144 * 2048; g.M = 8192; g.N = 512; g.K = 2048;
  OneUnit S; S.pm = pm; S.pn = pn;
  EpiG1 E; E.P = (u16*)(p.ws + OFF_P); E.out = p.out; E.ROPE = (const float2*)(p.ws + OFF_ROPE); E.l = l; E.colbase = 6144;
  pg8::gemm_phase<EpiG1, OneUnit, false>((PG8_LAS unsigned char*)dyn_smem, g, S, E, nullptr);
  if (threadIdx.x == 0) {
    __builtin_amdgcn_fence(__ATOMIC_RELEASE, "agent");
    asm volatile("s_waitcnt vmcnt(0)" ::: "memory");
    __hip_atomic_store((unsigned*)(p.ws + OFF_CNT) + FLG_WORD0 + l * 64 + pm * 2 + pn, 1u, __ATOMIC_RELAXED, __HIP_MEMORY_SCOPE_AGENT);
  }
}
DEV void wait_tail_flags(const Params& p, int l, int pm0, int npm, int pn) {
  unsigned* f = (unsigned*)(p.ws + OFF_CNT) + FLG_WORD0 + l * 64 + pn;
  for (int k = 0; k < npm; k++) {
    unsigned sp = 0;
    while (__hip_atomic_load(f + (pm0 + k) * 2, __ATOMIC_RELAXED, __HIP_MEMORY_SCOPE_AGENT) == 0u) {
      __builtin_amdgcn_s_sleep(2);
      if (++sp > (1u << 22)) break;
    }
  }
  __builtin_amdgcn_fence(__ATOMIC_ACQUIRE, "agent");
  asm volatile("s_waitcnt vmcnt(0)" ::: "memory");
}

DEV void mm128(const char* Al, const char* Bl, f32x4 (&acc)[2][8], int wave, int lane) {
  const int l15 = lane & 15, quad = lane >> 4, q4 = l15 >> 2, p4 = lane & 3;
  const unsigned bbase = (unsigned)(size_t)Bl + (quad * 8 + q4) * 288 + p4 * 8;
#pragma unroll
  for (int ks = 0; ks < 4; ks++) {
    bf16x8 a[2];
#pragma unroll
    for (int mt = 0; mt < 2; mt++) a[mt] = *(const bf16x8*)(Al + (wave * 32 + mt * 16 + l15) * 272 + ks * 64 + quad * 16);
#pragma unroll
    for (int nb4 = 0; nb4 < 2; nb4++) {
      bf16x8 b[4];
      tr_read2x4(bbase + ks * 32 * 288 + nb4 * 128, bbase + ks * 32 * 288 + 4 * 288 + nb4 * 128, 32, b);
#pragma unroll
      for (int q = 0; q < 4; q++)
#pragma unroll
        for (int mt = 0; mt < 2; mt++) acc[mt][nb4 * 4 + q] = mfma16(a[mt], b[q], acc[mt][nb4 * 4 + q]);
    }
  }
}

DEV void load_f32_tile_bf16(const float* src, char* dst, int stride_bytes) {
  const int tid = launder_tid();
#pragma unroll
  for (int i = 0; i < 8; i++) {
    int idx = tid + 256 * i, r = idx >> 4, c8 = idx & 15;
    float4 a = *(const float4*)(src + r * 128 + c8 * 8), b = *(const float4*)(src + r * 128 + c8 * 8 + 4);
    float f[8] = {a.x, a.y, a.z, a.w, b.x, b.y, b.z, b.w};
    *(bf16x8*)(dst + r * stride_bytes + c8 * 16) = pack8(f);
  }
}

DEV void gmlp_item(const Params& p, int l, int chunk, int g, char* smem) {
  char* Al = smem;
  char* Bl = smem + 34816;
  const int tid = launder_tid(), lane = tid & 63, wave = tid >> 6, l15 = lane & 15, quad = lane >> 4;
  const u16* P = (const u16*)(p.ws + OFF_P);
  u16* Y = (u16*)(p.ws + OFF_Y);
  const int r0 = chunk * 128;
  load_f32_tile_bf16(p.gmlp_w + (size_t)(l * 4 + g) * 16384, Al, 272);
#pragma unroll 1
  for (int rb = 0; rb < 4; rb++) {
    bf16x8 vv[8];
#pragma unroll
    for (int k = 0; k < 8; k++) vv[k] = *(const bf16x8*)(P + (size_t)(r0 + wave * 32 + rb * 8 + k) * 6656 + 512 + lane * 8);
#pragma unroll
    for (int k = 0; k < 8; k++) {
      const int j = wave * 32 + rb * 8 + k;
      float f[8];
      float sm1 = 0.f;
#pragma unroll
      for (int e = 0; e < 8; e++) { f[e] = bf2f(vv[k][e]); sm1 += f[e]; }
      const float mean = wave_sum(sm1) * (1.f / 512.f);
      float q = 0.f;
#pragma unroll
      for (int e = 0; e < 8; e++) { f[e] -= mean; q += f[e] * f[e]; }
      const float rstd = rsqrtf(wave_sum(q) * (1.f / 512.f) + 1e-6f);
      if (quad == g) {
#pragma unroll
        for (int e = 0; e < 8; e++) f[e] *= rstd;
        *(bf16x8*)(Bl + j * 288 + l15 * 16) = pack8(f);
      }
    }
  }
  __syncthreads();
  f32x4 acc[2][8];
#pragma unroll
  for (int i = 0; i < 2; i++)
#pragma unroll
    for (int j = 0; j < 8; j++) acc[i][j] = (f32x4){0.f, 0.f, 0.f, 0.f};
  mm128(Al, Bl, acc, wave, lane);
  __syncthreads();
  float* Ct = (float*)smem + wave * 32 * 132;
#pragma unroll
  for (int mt = 0; mt < 2; mt++)
#pragma unroll
    for (int nt = 0; nt < 8; nt++)
#pragma unroll
      for (int j = 0; j < 4; j++) Ct[(mt * 16 + quad * 4 + j) * 132 + nt * 16 + l15] = acc[mt][nt][j];
#pragma unroll 4
  for (int k = 0; k < 8; k++) {
    const int id = lane + 64 * k, r = id >> 4, c8 = (id & 15) * 8;
    const int i = wave * 32 + r;
    const float bs = p.gmlp_b[(l * 4 + g) * 128 + i];
    const u16* pr = P + (size_t)(r0 + i) * 6656 + g * 128 + c8;
    bf16x8 uv = *(const bf16x8*)pr;
    bf16x8 gv = *(const bf16x8*)(pr + 1024);
    float4 a0 = *(const float4*)(Ct + r * 132 + c8), a1 = *(const float4*)(Ct + r * 132 + c8 + 4);
    float av[8] = {a0.x, a0.y, a0.z, a0.w, a1.x, a1.y, a1.z, a1.w};
    float f[8];
#pragma unroll
    for (int e = 0; e < 8; e++) f[e] = silu(bf2f(gv[e])) * bf2f(uv[e]) * (av[e] + bs);
    *(bf16x8*)(Y + (size_t)(r0 + i) * 2048 + g * 128 + c8) = pack8(f);
  }
  __syncthreads();
}

DEV void pool_item(const Params& p, int l, int tile, int g, char* smem) {
  char* Sl = smem;
  char* Al = smem + 36864;
  const int tid = launder_tid(), lane = tid & 63, wave = tid >> 6, l15 = lane & 15, quad = lane >> 4;
  const u16* P = (const u16*)(p.ws + OFF_P);
  u16* Y = (u16*)(p.ws + OFF_Y);
  const int r0 = tile * 128;
  int s0, L;
  if (r0 < 4096) { s0 = r0 & ~255; L = 256; } else { s0 = 4096 + ((r0 - 4096) & ~1023); L = 1024; }
  const int w2 = 1 << g;
  for (int idx = tid; idx < 144 * 16; idx += 256) {
    int rr = idx >> 4, c8 = idx & 15;
    int row = r0 - 8 + rr;
    bf16x8 v = (bf16x8){0, 0, 0, 0, 0, 0, 0, 0};
    if (row >= s0 && row < s0 + L) v = *(const bf16x8*)(P + (size_t)row * 6656 + 3 * 512 + g * 128 + c8 * 8);
    *(bf16x8*)(Sl + rr * 256 + c8 * 16) = v;
  }
  __syncthreads();
#pragma unroll 1
  for (int i = 0; i < 8; i++) {
    int idx = tid + 256 * i, t = idx >> 4, c8 = idx & 15;
    int tl = r0 + t - s0;
    int lo = max(tl - w2, 0), hi = min(tl + w2, L);
    float s[8];
#pragma unroll
    for (int e = 0; e < 8; e++) s[e] = 0.f;
    for (int u = lo; u < hi; u++) {
      bf16x8 v = *(const bf16x8*)(Sl + (u - tl + t + 8) * 256 + c8 * 16);
#pragma unroll
      for (int e = 0; e < 8; e++) s[e] += bf2f(v[e]);
    }
    const float inv = 1.f / (float)(hi - lo);
    bf16x8 cv = *(const bf16x8*)(Sl + (t + 8) * 256 + c8 * 16);
#pragma unroll
    for (int e = 0; e < 8; e++) s[e] = s[e] * inv - bf2f(cv[e]);
    *(bf16x8*)(Al + t * 272 + c8 * 16) = pack8(s);
  }
  __syncthreads();
  load_f32_tile_bf16(p.pool_w + (size_t)(l * 4 + g) * 16384, Sl, 288);
  __syncthreads();
  f32x4 acc[2][8];
#pragma unroll
  for (int i = 0; i < 2; i++)
#pragma unroll
    for (int j = 0; j < 8; j++) acc[i][j] = (f32x4){0.f, 0.f, 0.f, 0.f};
  mm128(Al, Sl, acc, wave, lane);
  __syncthreads();
  float* Ct = (float*)smem + wave * 32 * 132;
#pragma unroll
  for (int mt = 0; mt < 2; mt++)
#pragma unroll
    for (int nt = 0; nt < 8; nt++)
#pragma unroll
      for (int j = 0; j < 4; j++) Ct[(mt * 16 + quad * 4 + j) * 132 + nt * 16 + l15] = acc[mt][nt][j];
#pragma unroll 4
  for (int k = 0; k < 8; k++) {
    const int id = lane + 64 * k, r = id >> 4, c8 = (id & 15) * 8;
    const int row = r0 + wave * 32 + r;
    bf16x8 gv = *(const bf16x8*)(P + (size_t)row * 6656 + 4 * 512 + g * 128 + c8);
    const float* psc = p.pool_scale + l * 512 + g * 128 + c8;
    float4 s0 = *(const float4*)psc, s1 = *(const float4*)(psc + 4);
    float sv[8] = {s0.x, s0.y, s0.z, s0.w, s1.x, s1.y, s1.z, s1.w};
    float4 a0 = *(const float4*)(Ct + r * 132 + c8), a1 = *(const float4*)(Ct + r * 132 + c8 + 4);
    float av[8] = {a0.x, a0.y, a0.z, a0.w, a1.x, a1.y, a1.z, a1.w};
    float f[8];
#pragma unroll
    for (int e = 0; e < 8; e++) f[e] = av[e] * sv[e] * silu(bf2f(gv[e]));
    *(bf16x8*)(Y + (size_t)row * 2048 + 512 + g * 128 + c8) = pack8(f);
  }
  __syncthreads();
}

DEV void attn_item(const Params& p, int l, int path, int b, int h, int qb, char* smem) {
  char* Kl = smem;
  char* Vl = smem + 17408;
  float* Ol = (float*)smem;
  const int tid = launder_tid(), lane = tid & 63, wave = tid >> 6, l15 = lane & 15, quad = lane >> 4;
  const int q4 = l15 >> 2, p4 = lane & 3;
  const u16* P = (const u16*)(p.ws + OFF_P);
  u16* Y = (u16*)(p.ws + OFF_Y);
  const int rowbase = path ? 4096 + b * 1024 : b * 256;
  const int nkeys = path ? 1536 : 256;
  const int ncache = path ? 512 : 0;
  const float* lq = p.lambda_qk + l * 256;
  const float d01 = wave_sum(lq[lane] * lq[64 + lane]);
  const float d23 = wave_sum(lq[128 + lane] * lq[192 + lane]);
  const float lam_init = 0.8f - 0.6f * expf(-0.3f * (float)l);
  const float lam = expf(d01) - expf(d23) + lam_init;
  bf16x8 qf[2][2];
  {
    const int qrow = rowbase + qb * 64 + wave * 16 + l15;
#pragma unroll
    for (int m = 0; m < 2; m++)
#pragma unroll
      for (int ks = 0; ks < 2; ks++) {
        bf16x8 v = *(const bf16x8*)(P + (size_t)qrow * 6656 + 5 * 512 + h * 128 + m * 64 + ks * 32 + quad * 8);
#pragma unroll
        for (int e = 0; e < 8; e++) v[e] = (short)f2bf(bf2f(v[e]) * 0.125f);
        qf[m][ks] = v;
      }
  }
  f32x4 o[2][8];
#pragma unroll
  for (int m = 0; m < 2; m++)
#pragma unroll
    for (int dt = 0; dt < 8; dt++) o[m][dt] = (f32x4){0.f, 0.f, 0.f, 0.f};
  float mrun[2] = {-1e30f, -1e30f}, lrun[2] = {0.f, 0.f};
  const unsigned vbase = (unsigned)(size_t)Vl + (quad * 4 + q4) * 288 + p4 * 8;
  const u16* KC = (const u16*)(p.ws + OFF_KC);
  const u16* VC = (const u16*)(p.ws + OFF_VC);
  const int ntile = nkeys >> 6;
  bf16x8 rk[4], rv[4];
  auto gload = [&](int t) {
    const int kt0 = t * 64;
#pragma unroll
    for (int i = 0; i < 4; i++) {
      const int chunk = tid + 256 * i, key = chunk >> 4, dc = chunk & 15;
      const int kg = kt0 + key;
      if (kt0 < ncache) {
        const size_t off = (((size_t)b * 2 + l) * 512 + kg) * 512 + h * 128 + dc * 8;
        rk[i] = *(const bf16x8*)(KC + off);
        rv[i] = *(const bf16x8*)(VC + off);
      } else {
        const size_t row = rowbase + (kg - ncache);
        rk[i] = *(const bf16x8*)(P + row * 6656 + 6 * 512 + h * 128 + dc * 8);
        rv[i] = *(const bf16x8*)(P + row * 6656 + 7 * 512 + h * 128 + dc * 8);
      }
    }
  };
  auto lstore = [&](int st) {
#pragma unroll
    for (int i = 0; i < 4; i++) {
      const int chunk = tid + 256 * i, key = chunk >> 4, dc = chunk & 15;
      *(bf16x8*)(Kl + st * 35840 + key * 272 + dc * 16) = rk[i];
      *(bf16x8*)(Vl + st * 35840 + key * 288 + dc * 16) = rv[i];
    }
  };
  __syncthreads();
  gload(0);
  lstore(0);
  if (ntile > 1) gload(1);
  __syncthreads();
#pragma unroll 1
  for (int t = 0; t < ntile; t++) {
    const int stg = t & 1;
    const char* Kc = Kl + stg * 35840;
    const unsigned vb = vbase + stg * 35840;
    if (t + 1 < ntile) {
      lstore(stg ^ 1);
      if (t + 2 < ntile) gload(t + 2);
    }
    __builtin_amdgcn_sched_barrier(0);
    f32x4 s[2][4];
#pragma unroll
    for (int m = 0; m < 2; m++)
#pragma unroll
      for (int kt = 0; kt < 4; kt++) {
        f32x4 a4 = (f32x4){0.f, 0.f, 0.f, 0.f};
#pragma unroll
        for (int ks = 0; ks < 2; ks++) {
          bf16x8 a = *(const bf16x8*)(Kc + (kt * 16 + l15) * 272 + m * 128 + ks * 64 + quad * 16);
          a4 = mfma16(a, qf[m][ks], a4);
        }
        s[m][kt] = a4;
        if (kt & 1) __builtin_amdgcn_sched_barrier(0);
      }
    bf16x8 pf[2][2];
#pragma unroll
    for (int m = 0; m < 2; m++) {
      float tmax = -1e30f;
#pragma unroll
      for (int kt = 0; kt < 4; kt++)
#pragma unroll
        for (int j = 0; j < 4; j++) tmax = fmaxf(tmax, s[m][kt][j]);
      tmax = fmaxf(tmax, __shfl_xor(tmax, 16));
      tmax = fmaxf(tmax, __shfl_xor(tmax, 32));
      const float mnew = fmaxf(mrun[m], tmax);
      const float alpha = __expf(mrun[m] - mnew);
      mrun[m] = mnew;
      float psum = 0.f;
#pragma unroll
      for (int kt = 0; kt < 4; kt++)
#pragma unroll
        for (int j = 0; j < 4; j++) {
          float pv = __expf(s[m][kt][j] - mnew);
          psum += pv;
          s[m][kt][j] = pv;
        }
      lrun[m] = lrun[m] * alpha + psum;
#pragma unroll
      for (int dt = 0; dt < 8; dt++) {
        o[m][dt][0] *= alpha; o[m][dt][1] *= alpha; o[m][dt][2] *= alpha; o[m][dt][3] *= alpha;
      }
#pragma unroll
      for (int kk = 0; kk < 2; kk++) {
        bf16x8 t;
#pragma unroll
        for (int j = 0; j < 4; j++) {
          t[j] = (short)f2bf(s[m][2 * kk][j]);
          t[4 + j] = (short)f2bf(s[m][2 * kk + 1][j]);
        }
        pf[m][kk] = t;
      }
    }
#pragma unroll
    for (int kk = 0; kk < 2; kk++)
#pragma unroll
      for (int d4 = 0; d4 < 2; d4++) {
        bf16x8 a[4];
        tr_read2x4(vb + (2 * kk) * 16 * 288 + d4 * 128, vb + (2 * kk + 1) * 16 * 288 + d4 * 128, 32, a);
#pragma unroll
        for (int q = 0; q < 4; q++) {
          o[0][d4 * 4 + q] = mfma16(a[q], pf[0][kk], o[0][d4 * 4 + q]);
          o[1][d4 * 4 + q] = mfma16(a[q], pf[1][kk], o[1][d4 * 4 + q]);
        }
        __builtin_amdgcn_sched_barrier(0);
      }
    __syncthreads();
  }
  float l0 = lrun[0], l1 = lrun[1];
  l0 += __shfl_xor(l0, 16); l0 += __shfl_xor(l0, 32);
  l1 += __shfl_xor(l1, 16); l1 += __shfl_xor(l1, 32);
  const float i0 = 1.f / l0, i1 = lam / l1;
  float ss = 0.f;
#pragma unroll
  for (int dt = 0; dt < 8; dt++)
#pragma unroll
    for (int j = 0; j < 4; j++) {
      float v = o[0][dt][j] * i0 - o[1][dt][j] * i1;
      o[0][dt][j] = v;
      ss += v * v;
    }
  ss += __shfl_xor(ss, 16);
  ss += __shfl_xor(ss, 32);
  const float sc = rsqrtf(ss * (1.f / 128.f) + 1e-5f) * (1.f - lam_init);
  __syncthreads();
#pragma unroll
  for (int dt = 0; dt < 8; dt++)
#pragma unroll
    for (int j = 0; j < 4; j++) Ol[(wave * 16 + l15) * 132 + dt * 16 + quad * 4 + j] = o[0][dt][j] * sc;
  __syncthreads();
#pragma unroll
  for (int i = 0; i < 4; i++) {
    const int idx = tid + 256 * i, qr = idx >> 4, dc = idx & 15;
    const size_t row = rowbase + qb * 64 + qr;
    bf16x8 gv = *(const bf16x8*)(P + row * 6656 + 8 * 512 + h * 128 + dc * 8);
    float f[8];
#pragma unroll
    for (int e = 0; e < 8; e++) f[e] = Ol[qr * 132 + dc * 8 + e] * p.subln_w[l * 128 + dc * 8 + e] * silu(bf2f(gv[e]));
    *(bf16x8*)(Y + row * 2048 + 1024 + h * 128 + dc * 8) = pack8(f);
  }
  __syncthreads();
}

template <int L, int CG>
DEV void hyena_item(const Params& p, int l, int path, int b, int cgi, char* smem) {
  constexpr int ZLEN = L + 512;
  constexpr int XLEN = 2 * L + 16;
  constexpr int FBL = 2 * L + 32;
  constexpr int NG = L / 256;
  constexpr int NCH = CG / 8;
  u16* zb = (u16*)smem;
  u16* g1b = zb + CG * ZLEN;
  u16* fball = g1b + CG * L;
  const int tid = launder_tid(), lane = tid & 63, wave = tid >> 6, l15 = lane & 15, quad = lane >> 4;
  const u16* P = (const u16*)(p.ws + OFF_P);
  u16* Y = (u16*)(p.ws + OFF_Y);
  const int rowbase = path ? 4096 + b * 1024 : b * 256;
  const int c0 = cgi * CG;
  const float* cw = p.conv_w + l * 3 * 1536;
  const float* cb = p.conv_b + l * 1536;
  __syncthreads();
  for (int i = tid; i < CG * 512; i += 256) {
    int c = i >> 9, x = i & 511;
    zb[c * ZLEN + (x < 256 ? x : L + x)] = 0;
  }
  if (lane < 16) fball[wave * FBL + lane] = 0;
  constexpr int NREG = (XLEN / 8 + 63) / 64;
  constexpr int NQ = (CG / 4) * 2;
  const u16* Fg = (const u16*)(p.ws + (path ? OFF_F1 : OFF_F0));
  const float* FN = (const float*)(p.ws + OFF_FN);
  bf16x8 frA[NREG], frB[NREG];
  float nrmA = 0.f, biasA = 0.f, nrmB = 0.f, biasB = 0.f;
  auto fetch_filter = [&](int q, bf16x8 (&fr)[NREG], float& nrm_pf, float& bias_pf) {
    const int chq = c0 + wave + 4 * (q >> 1), oq = q & 1;
    const u16* R = Fg + ((size_t)((l * 2 + oq) * 512 + chq)) * XLEN;
#pragma unroll
    for (int k = 0; k < NREG; k++) {
      const int i = lane + 64 * k;
      if (i < XLEN / 8) fr[k] = *(const bf16x8*)(R + i * 8);
    }
    nrm_pf = 0.f;
    if (lane < 2 * (L / 32)) nrm_pf = FN[((((path * 2 + l) * 4 + oq * 2 + (lane & 1)) * 32) + (lane >> 1)) * 512 + chq];
    bias_pf = p.hyena_bias[(l * 2 + oq) * 512 + chq];
  };
  fetch_filter(0, frA, nrmA, biasA);
  const bf16x8 zero8 = (bf16x8){0, 0, 0, 0, 0, 0, 0, 0};
#pragma unroll
  for (int cc = 0; cc < NCH; cc++) {
    const int ch = c0 + cc * 8;
#pragma unroll
    for (int it = 0; it < L / 256; it++) {
      const int t = tid + it * 256;
      bf16x8 xv[3], hv[3];
#pragma unroll
      for (int dtp = 0; dtp < 3; dtp++) {
        const int tt = t + dtp - 1;
        const int ttc = min(max(tt, 0), L - 1);
        const u16* pr = P + (size_t)(rowbase + ttc) * 6656;
        xv[dtp] = *(const bf16x8*)(pr + 9 * 512 + ch);
        hv[dtp] = *(const bf16x8*)(pr + 11 * 512 + ch);
        if (tt != ttc) { xv[dtp] = zero8; hv[dtp] = zero8; }
      }
      float z[8], g1[8];
#pragma unroll
      for (int e = 0; e < 8; e++) { z[e] = cb[1024 + ch + e]; g1[e] = cb[ch + e]; }
#pragma unroll
      for (int dtp = 0; dtp < 3; dtp++)
#pragma unroll
        for (int e = 0; e < 8; e++) {
          g1[e] += bf2f(xv[dtp][e]) * cw[dtp * 1536 + ch + e];
          z[e] += bf2f(hv[dtp][e]) * cw[dtp * 1536 + 1024 + ch + e];
        }
#pragma unroll
      for (int e = 0; e < 8; e++) {
        zb[(cc * 8 + e) * ZLEN + 256 + t] = f2bf(z[e]);
        g1b[(cc * 8 + e) * L + t] = f2bf(g1[e]);
      }
    }
  }
  __syncthreads();
  u16* fb = fball + wave * FBL;
  auto conv_step = [&](int q, bf16x8 (&fr)[NREG], float nrm_pf, float bias_pf, bf16x8 (&frn)[NREG], float& nrmn, float& biasn) {
    const int cl = wave + 4 * (q >> 1);
    const int o = q & 1;
    u16* zc = zb + cl * ZLEN;
    {
#pragma unroll
      for (int k = 0; k < NREG; k++) {
        const int i = lane + 64 * k;
        if (i < XLEN / 8) *(bf16x8*)(fb + 16 + i * 8) = fr[k];
      }
      const float invn = 1.f / wave_sum(nrm_pf);
      const float bias = bias_pf;
      if (q + 1 < NQ) fetch_filter(q + 1, frn, nrmn, biasn);
      f32x4 acc[NG];
#pragma unroll
      for (int ng = 0; ng < NG; ng++) acc[ng] = (f32x4){0.f, 0.f, 0.f, 0.f};
      const int ebase = L - l15 + quad * 8 + 16;
#pragma unroll 2
      for (int u = -256; u <= L - 32; u += 32) {
        const bf16x8 bz = *(const bf16x8*)(zc + 256 + u + l15 * 16 + quad * 8);
#pragma unroll
        for (int ng = 0; ng < NG; ng++) {
          const int e0 = ebase - ng * 256 + u;
          const unsigned* fw = (const unsigned*)fb + (e0 >> 1);
          const unsigned sh = (e0 & 1) * 2;
          unsigned d0 = fw[0], d1 = fw[1], d2 = fw[2], d3 = fw[3], d4 = fw[4];
          union { unsigned u4[4]; bf16x8 v; } af;
          af.u4[0] = __builtin_amdgcn_alignbyte(d1, d0, sh);
          af.u4[1] = __builtin_amdgcn_alignbyte(d2, d1, sh);
          af.u4[2] = __builtin_amdgcn_alignbyte(d3, d2, sh);
          af.u4[3] = __builtin_amdgcn_alignbyte(d4, d3, sh);
          acc[ng] = mfma16(af.v, bz, acc[ng]);
        }
      }
#pragma unroll
      for (int ng = 0; ng < NG; ng++) {
        const int t = ng * 256 + l15 * 16 + quad * 4;
        bf16x4 zv = *(const bf16x4*)(zc + 256 + t);
        bf16x4 ov;
        if (o == 0) {
          bf16x4 gv = *(const bf16x4*)(g1b + cl * L + t);
#pragma unroll
          for (int j = 0; j < 4; j++) ov[j] = (short)f2bf(bf2f(gv[j]) * (acc[ng][j] * invn + bf2f(zv[j]) * bias));
        } else {
#pragma unroll
          for (int j = 0; j < 4; j++) ov[j] = (short)f2bf(acc[ng][j] * invn + bf2f(zv[j]) * bias);
        }
        *(bf16x4*)(zc + 256 + t) = ov;
      }
    }
  };
#pragma unroll 1
  for (int q = 0; q < NQ; q += 2) {
    conv_step(q, frA, nrmA, biasA, frB, nrmB, biasB);
    conv_step(q + 1, frB, nrmB, biasB, frA, nrmA, biasA);
  }
  if (tid == 0) {
    if (path) wait_tail_flags(p, l, 16 + 4 * b, 4, c0 >> 8);
    else wait_tail_flags(p, l, b, 1, c0 >> 8);
  }
  __syncthreads();
#pragma unroll
  for (int cc = 0; cc < NCH; cc++) {
    const int ch = c0 + cc * 8;
#pragma unroll
    for (int it = 0; it < L / 256; it++) {
      const int t = tid + it * 256;
      bf16x8 xv[3];
#pragma unroll
      for (int dtp = 0; dtp < 3; dtp++) {
        const int tt = t + dtp - 1;
        const int ttc = min(max(tt, 0), L - 1);
        xv[dtp] = *(const bf16x8*)(P + (size_t)(rowbase + ttc) * 6656 + 10 * 512 + ch);
        if (tt != ttc) xv[dtp] = zero8;
      }
      const bf16x8 dg = *(const bf16x8*)(P + (size_t)(rowbase + t) * 6656 + 12 * 512 + ch);
      float g2[8];
#pragma unroll
      for (int e = 0; e < 8; e++) g2[e] = cb[512 + ch + e];
#pragma unroll
      for (int dtp = 0; dtp < 3; dtp++)
#pragma unroll
        for (int e = 0; e < 8; e++) g2[e] += bf2f(xv[dtp][e]) * cw[dtp * 1536 + 512 + ch + e];
      float f[8];
#pragma unroll
      for (int e = 0; e < 8; e++) f[e] = bf2f((short)zb[(cc * 8 + e) * ZLEN + 256 + t]) * g2[e] * silu(bf2f(dg[e]));
      *(bf16x8*)(Y + (size_t)(rowbase + t) * 2048 + 1536 + ch) = pack8(f);
    }
  }
  __syncthreads();
}

#ifndef R_HY
#define R_HY 1
#endif
#ifndef R_AT
#define R_AT 1
#endif
#ifndef R_GP
#define R_GP 1
#endif
DEV void phase_mix(const Params& p, int l, int bid, int nb, char* smem) {
  constexpr int N_HL = 256, N_AL = 256, N_HC = 512, N_AC = 256, N_G = 256, N_PL = 256;
  constexpr int TOT0 = N_HL + N_AL + N_HC + N_AC + N_G + N_PL;
  const int TOT = TOT0 + (l == 0 ? 1088 : 0);
  const int team = __builtin_amdgcn_readfirstlane(threadIdx.x >> 8);
  smem += team * LDS_TEAM;
  volatile LAS unsigned* stq = (volatile LAS unsigned*)(dyn_smem + LDS_MAIN);
  unsigned* cnt = (unsigned*)(p.ws + OFF_CNT) + 16 * (1 + l);
  for (;;) {
    __syncthreads();
    if (threadIdx.x == 0) stq[2] = atomicAdd(cnt, 1u);
    __syncthreads();
    int jp = (int)stq[2];
    if (jp >= 64 + TOT / 2) break;
    if (jp < 64) { gemm1_tail_unit(p, l, jp); continue; }
    jp -= 64;
    int i = jp * 2 + team;
    if (i < N_HL) { for (int r = 0; r < R_HY; r++) hyena_item<1024, 8>(p, l, 1, i >> 6, i & 63, smem); continue; }
    i -= N_HL;
    if (i < N_AL) { for (int r = 0; r < R_AT; r++) attn_item(p, l, 1, i >> 6, (i >> 4) & 3, i & 15, smem); continue; }
    i -= N_AL;
    if (i < N_HC) { for (int r = 0; r < R_HY; r++) hyena_item<256, 16>(p, l, 0, i >> 5, i & 31, smem); continue; }
    i -= N_HC;
    if (i < N_AC) { for (int r = 0; r < R_AT; r++) attn_item(p, l, 0, i >> 4, (i >> 2) & 3, i & 3, smem); continue; }
    i -= N_AC;
    if (i < N_G) { for (int r = 0; r < R_GP; r++) gmlp_item(p, l, i >> 2, i & 3, smem); continue; }
    i -= N_G;
    if (i < N_PL) { for (int r = 0; r < R_GP; r++) pool_item(p, l, i >> 2, i & 3, smem); continue; }
    i -= N_PL;
    if (i < 832) {
      p0_transpose(p.w_in + (size_t)2048 * 6656, (u16*)(p.ws + OFF_WINT) + (size_t)6656 * 2048, 2048, 6656, i / 26, i % 26, smem);
    } else {
      i -= 832;
      p0_transpose(p.w_out + (size_t)2048 * 2048, (u16*)(p.ws + OFF_WOUTT) + (size_t)2048 * 2048, 2048, 2048, i / 8, i % 8, smem);
    }
  }
}


#ifndef REP_PREP
#define REP_PREP 1
#endif
#ifndef REP_ROWS
#define REP_ROWS 1
#endif
#ifndef REP_G1
#define REP_G1 1
#endif
#ifndef REP_MIX
#define REP_MIX 1
#endif
#ifndef REP_G2
#define REP_G2 1
#endif
__global__ void __launch_bounds__(512, 2) mega_kernel(Params p) {
  cg::grid_group grid = cg::this_grid();
  const int bid = blockIdx.x, nb = gridDim.x;
  volatile LAS unsigned* st = (volatile LAS unsigned*)(dyn_smem + LDS_MAIN);
  if (threadIdx.x < 4) st[threadIdx.x] = 0u;
  __syncthreads();
  XcdBarrier xb = xcd_barrier_post((unsigned*)(p.ws + OFF_BAR), st);
  if (p.out == nullptr) grid.sync();
#pragma unroll 1
  for (int r = 0; r < REP_PREP; r++) {
    phase_prep(p, bid, nb, dyn_smem);
    xcd_barrier(xb);
  }
#pragma unroll 1
  for (int l = 0; l < 2; l++) {
#pragma unroll 1
    for (int r = 0; r < REP_ROWS; r++) {
      phase_rows(p, l, l, bid, nb, dyn_smem);
      xcd_barrier(xb);
    }
#pragma unroll 1
    for (int r = 0; r < REP_G1; r++) {
      phase_gemm<1>(p, l, bid, nb, dyn_smem);
      xcd_barrier(xb);
    }
#pragma unroll 1
    for (int r = 0; r < REP_MIX; r++) {
      phase_mix(p, l, bid, nb, dyn_smem);
      xcd_barrier(xb);
    }
#pragma unroll 1
    for (int r = 0; r < REP_G2; r++) {
      phase_gemm<2>(p, l, bid, nb, dyn_smem);
      xcd_barrier(xb);
    }
  }
  phase_rows(p, 2, 1, bid, nb, dyn_smem);
}

extern "C" void kernel_launch(void* const* d_in, const int* in_sizes, int n_in, void* d_out, int out_size, void* d_ws,
                              size_t ws_size, hipStream_t stream) {
  static int grid_blocks = 0;
  if (!grid_blocks) {
    int dev = 0, cus = 0, per_cu = 0;
    (void)hipGetDevice(&dev);
    (void)hipDeviceGetAttribute(&cus, hipDeviceAttributeMultiprocessorCount, dev);
    (void)hipFuncSetAttribute((const void*)mega_kernel, hipFuncAttributeMaxDynamicSharedMemorySize, LDS_BYTES);
    (void)hipOccupancyMaxActiveBlocksPerMultiprocessor(&per_cu, mega_kernel, 512, LDS_BYTES);
    if (per_cu < 1) per_cu = 1;
    if (per_cu > 1) per_cu = 1;
    grid_blocks = cus * per_cu;
  }
  Params p{};
  const float** pp = (const float**)&p;
  for (int i = 0; i < 28; i++) pp[i] = (const float*)d_in[i];
  p.out = (float*)d_out;
  p.ws = (char*)d_ws;
  (void)hipMemsetAsync((char*)d_ws + OFF_BAR, 0, 16384, stream);
  void* args[] = {&p};
  hipError_t e = hipLaunchCooperativeKernel((const void*)mega_kernel, dim3(grid_blocks), dim3(512), args, LDS_BYTES, stream);
  if (e != hipSuccess) fprintf(stderr, "cooperative launch failed: %s (grid %d)\n", hipGetErrorString(e), grid_blocks);
}
```
